# Optimizing an MI355X kernel written in HIP

```python
import math
import jax
import jax.numpy as jnp
from jax import lax
import numpy as np

D_MODEL = 1024
BATCH = 4
SEQ = 8192
DEPTH = 2

HEAD_DIM = 64
A_HEADS = 6
A_CONFIGS = ((128, 1), (512, 4), (2048, 16))
B_HEADS = 4
B_KV_HEADS = 2
B_RADIUS = 128
C_HEADS = 6
C_NOPE = 64
C_ROPE = 32
C_VDIM = 64
C_QK = C_NOPE + C_ROPE
C_Q_RANK = 256
C_KV_RANK = 128
ROPE_THETA = 10000.0
Q_BLOCK = 128
N_BUCKETS = 32
MAX_DISTANCE = 1024
BIAS_HEADS = A_HEADS + B_HEADS
D_FF = 4 * D_MODEL
EPS = 1e-6
NEG = -1e30

A_W = A_HEADS * HEAD_DIM
B_QW = B_HEADS * HEAD_DIM
B_KVW = B_KV_HEADS * HEAD_DIM
C_OW = C_HEADS * C_VDIM
D_MIX = A_W + B_QW + C_OW
IN_SPLITS = (A_W, A_W, A_W, B_QW, B_KVW, B_KVW, C_Q_RANK, C_KV_RANK, C_ROPE)
IN_WIDTH = 3 * A_W + B_QW + 2 * B_KVW + C_Q_RANK + C_KV_RANK + C_ROPE

kernel_name = 'hybrid_parallel_heads_encoder'


def rmsnorm(x, g):
    xf = x.astype(jnp.float32)
    y = xf * lax.rsqrt(jnp.mean(xf * xf, axis=-1, keepdims=True) + EPS)
    return (y * g.astype(jnp.float32)).astype(x.dtype)


def split_heads(t, n):
    return t.reshape(t.shape[0], t.shape[1], n, -1)


def t5_bucket(rel):
    half = N_BUCKETS // 2
    exact = half // 2
    n = jnp.abs(rel)
    far = exact + (jnp.log(jnp.maximum(n, 1).astype(jnp.float32) / exact)
                   / math.log(MAX_DISTANCE / exact) * (half - exact)).astype(jnp.int32)
    far = jnp.minimum(far, half - 1)
    return jnp.where(rel > 0, half, 0) + jnp.where(n < exact, n, far)


def band_rel(blk):
    return jnp.arange(3 * blk)[None, :] - blk - jnp.arange(blk)[:, None]


def rel_bias(table, dist):
    return jnp.transpose(table[t5_bucket(dist)], (2, 0, 1))


def banded_attention(q, k, v, radius, bias, sink=None):
    b, L, hq, d = q.shape
    hkv = k.shape[2]
    g = hq // hkv
    blk = radius
    nb = -(-L // blk)
    pad = nb * blk - L
    qb = jnp.pad(q, ((0, 0), (0, pad), (0, 0), (0, 0))).reshape(b, nb, blk, hkv, g, d)

    def windows(t):
        tp = jnp.pad(t, ((0, 0), (blk, pad + blk), (0, 0), (0, 0))).reshape(b, nb + 2, blk, hkv, d)
        return jnp.concatenate([tp[:, :-2], tp[:, 1:-1], tp[:, 2:]], axis=2)

    kw, vw = windows(k), windows(v)
    s = jnp.einsum('bnqhgd,bnkhd->bnhgqk', qb, kw, preferred_element_type=jnp.float32) * (d ** -0.5)
    s = s + bias.astype(jnp.float32).reshape(hkv, g, blk, 3 * blk)
    rel = band_rel(blk)
    kpos = jnp.arange(nb)[:, None, None] * blk + jnp.arange(3 * blk)[None, None, :] - blk
    mask = (jnp.abs(rel)[None] <= radius) & (kpos >= 0) & (kpos < L)
    s = jnp.where(mask[None, :, None, None], s, NEG)
    m = jnp.max(s, axis=-1)
    if sink is not None:
        sk = sink.astype(jnp.float32).reshape(hkv, g)[None, None, :, :, None]
        m = jnp.maximum(m, sk)
    p = jnp.exp(s - m[..., None])
    l = jnp.sum(p, axis=-1)
    if sink is not None:
        l = l + jnp.exp(sk - m)
    o = jnp.einsum('bnhgqk,bnkhd->bnqhgd', p.astype(v.dtype), vw, preferred_element_type=jnp.float32)
    l_t = jnp.transpose(l, (0, 1, 4, 2, 3))
    m_t = jnp.transpose(m, (0, 1, 4, 2, 3))
    o = (o / l_t[..., None]).astype(v.dtype).reshape(b, nb * blk, hq, d)[:, :L]
    return o, m_t.reshape(b, nb * blk, hq)[:, :L], l_t.reshape(b, nb * blk, hq)[:, :L]


def dilated_attention(q, k, v, table):
    b, L, h, d = q.shape
    outs, ms, ls = [], [], []
    for window, r in A_CONFIGS:
        radius = window // (2 * r)
        n = L // r

        def by_residue(t):
            return t.reshape(b, n, r, h, d).transpose(0, 2, 1, 3, 4).reshape(b * r, n, h, d)

        bias = rel_bias(table, band_rel(radius) * r)
        o, m, l = banded_attention(by_residue(q), by_residue(k), by_residue(v), radius, bias)
        outs.append(o.reshape(b, r, n, h, d).transpose(0, 2, 1, 3, 4).reshape(b, L, h, d).astype(jnp.float32))
        ms.append(m.reshape(b, r, n, h).transpose(0, 2, 1, 3).reshape(b, L, h))
        ls.append(l.reshape(b, r, n, h).transpose(0, 2, 1, 3).reshape(b, L, h))
    m_all = jnp.stack(ms)
    w = jnp.stack(ls) * jnp.exp(m_all - jnp.max(m_all, axis=0))
    o = jnp.einsum('cblh,cblhd->blhd', w, jnp.stack(outs)) / jnp.sum(w, axis=0)[..., None]
    return o.astype(q.dtype)


def rope(t, positions):
    half = t.shape[-1] // 2
    inv = ROPE_THETA ** (-jnp.arange(half, dtype=jnp.float32) / half)
    ang = positions.astype(jnp.float32)[:, :, None, None] * inv
    cos, sin = jnp.cos(ang), jnp.sin(ang)
    t1 = t[..., :half].astype(jnp.float32)
    t2 = t[..., half:].astype(jnp.float32)
    return jnp.concatenate([t1 * cos - t2 * sin, t2 * cos + t1 * sin], axis=-1).astype(t.dtype)


def latent_attention(q, k, v):
    b, L, h, dqk = q.shape
    nq = L // Q_BLOCK
    qb = q.reshape(b, nq, Q_BLOCK, h, dqk).transpose(1, 0, 2, 3, 4)

    def block(qblk):
        s = jnp.einsum('bqhd,bkhd->bhqk', qblk, k, preferred_element_type=jnp.float32) * (dqk ** -0.5)
        p = jax.nn.softmax(s, axis=-1)
        return jnp.einsum('bhqk,bkhd->bqhd', p.astype(v.dtype), v)

    o = lax.map(block, qb)
    return o.transpose(1, 0, 2, 3, 4).reshape(b, L, h, v.shape[-1])


def setup_inputs(seed: int = 0) -> dict:
    key = jax.random.key(seed)
    ks = jax.random.split(key, 20)

    def nrm(k, shape, scale):
        return jax.random.normal(k, shape, jnp.float32) * scale

    def gain(k, shape):
        return 1.0 + 0.02 * jax.random.normal(k, shape, jnp.float32)

    offset = jax.random.randint(ks[1], (BATCH, 1), 0, 4096, dtype=jnp.int32)
    positions = (jnp.arange(SEQ, dtype=jnp.int32)[None, :] + offset).astype(jnp.int32)
    return {
        'x': nrm(ks[0], (BATCH, SEQ, D_MODEL), 1.0),
        'positions': positions,
        'rel_bias_table': nrm(ks[2], (N_BUCKETS, BIAS_HEADS), 0.2),
        'norm_mix': gain(ks[3], (DEPTH, D_MODEL)),
        'w_in': nrm(ks[4], (DEPTH, D_MODEL, IN_WIDTH), D_MODEL ** -0.5),
        'qk_gain_a': gain(ks[5], (DEPTH, 2, HEAD_DIM)),
        'qk_gain_b': gain(ks[6], (DEPTH, 2, HEAD_DIM)),
        'sink_b': nrm(ks[7], (DEPTH, B_HEADS), 0.5),
        'q_lat_gain': gain(ks[8], (DEPTH, C_Q_RANK)),
        'kv_lat_gain': gain(ks[9], (DEPTH, C_KV_RANK)),
        'w_uq': nrm(ks[10], (DEPTH, C_Q_RANK, C_HEADS * C_QK), C_Q_RANK ** -0.5),
        'w_ukv': nrm(ks[11], (DEPTH, C_KV_RANK, C_HEADS * (C_NOPE + C_VDIM)), C_KV_RANK ** -0.5),
        'qk_gain_c': gain(ks[12], (DEPTH, 2, C_QK)),
        'out_norm': gain(ks[13], (DEPTH, D_MIX)),
        'w_out': nrm(ks[14], (DEPTH, D_MIX, D_MODEL), D_MIX ** -0.5),
        'norm_mlp': gain(ks[15], (DEPTH, D_MODEL)),
        'w_up': nrm(ks[16], (DEPTH, D_MODEL, D_FF), D_MODEL ** -0.5),
        'w_down': nrm(ks[17], (DEPTH, D_FF, D_MODEL), D_FF ** -0.5),
    }


def reference(x, positions, rel_bias_table, norm_mix, w_in, qk_gain_a, qk_gain_b, sink_b,
              q_lat_gain, kv_lat_gain, w_uq, w_ukv, qk_gain_c, out_norm, w_out,
              norm_mlp, w_up, w_down):
    b, L, _ = x.shape
    split_at = np.cumsum(IN_SPLITS)[:-1].tolist()
    table_a = rel_bias_table[:, :A_HEADS]
    bias_b = rel_bias(rel_bias_table[:, A_HEADS:], band_rel(B_RADIUS))
    for i in range(DEPTH):
        h = rmsnorm(x, norm_mix[i])
        qa, ka, va, qb, kb, vb, cq, ckv, kr = jnp.split(h @ w_in[i], split_at, axis=-1)

        qa = rmsnorm(split_heads(qa, A_HEADS), qk_gain_a[i, 0])
        ka = rmsnorm(split_heads(ka, A_HEADS), qk_gain_a[i, 1])
        o_a = dilated_attention(qa, ka, split_heads(va, A_HEADS), table_a)

        qb = rmsnorm(split_heads(qb, B_HEADS), qk_gain_b[i, 0])
        kb = rmsnorm(split_heads(kb, B_KV_HEADS), qk_gain_b[i, 1])
        o_b, _, _ = banded_attention(qb, kb, split_heads(vb, B_KV_HEADS), B_RADIUS, bias_b, sink_b[i])

        qc = split_heads(rmsnorm(cq, q_lat_gain[i]) @ w_uq[i], C_HEADS)
        kvc = split_heads(rmsnorm(ckv, kv_lat_gain[i]) @ w_ukv[i], C_HEADS)
        vc = kvc[..., C_NOPE:]
        kc = jnp.concatenate(
            [kvc[..., :C_NOPE], jnp.broadcast_to(kr[:, :, None, :], (b, L, C_HEADS, C_ROPE))], axis=-1)
        qc = rmsnorm(qc, qk_gain_c[i, 0])
        kc = rmsnorm(kc, qk_gain_c[i, 1])
        qc = jnp.concatenate([qc[..., :C_NOPE], rope(qc[..., C_NOPE:], positions)], axis=-1)
        kc = jnp.concatenate([kc[..., :C_NOPE], rope(kc[..., C_NOPE:], positions)], axis=-1)
        o_c = latent_attention(qc, kc, vc)

        g = out_norm[i]
        mixed = jnp.concatenate([
            rmsnorm(o_a.reshape(b, L, A_W), g[:A_W]),
            rmsnorm(o_b.reshape(b, L, B_QW), g[A_W:A_W + B_QW]),
            rmsnorm(o_c.reshape(b, L, C_OW), g[A_W + B_QW:]),
        ], axis=-1)
        x = x + mixed @ w_out[i]

        h = rmsnorm(x, norm_mlp[i])
        x = x + jnp.square(jax.nn.relu(h @ w_up[i])) @ w_down[i]
    return x
```

```cpp
#include <hip/hip_runtime.h>
#include <hip/hip_cooperative_groups.h>
#include <cstdio>
#include <cstdint>
namespace cg = cooperative_groups;
#ifndef MODE_COOP
#define MODE_COOP 1
#endif
namespace pg8 {
#define PG8_LAS __attribute__((address_space(3)))
typedef unsigned short bf16_t;
typedef short bf16x8 __attribute__((ext_vector_type(8)));
typedef float f32x4 __attribute__((ext_vector_type(4)));
typedef unsigned u32x4 __attribute__((ext_vector_type(4)));
constexpr int BM = 256, BK = 64, HALF = 128, HTB = HALF * BK * 2  , STAGE_BYTES = 8 * HTB, NXCD = 8, WGM = 8;

__host__ __device__ __forceinline__ int lds_byte(int r, int c) { const int st = (r >> 4) * 2 + (c >> 5), rr = r & 15, cc = c & 31, ob = rr * 64 + cc * 2; return st * 1024 + (ob ^ (((ob >> 9) & 1) << 5)); }
__host__ __device__ __forceinline__ void stage_rc(int b, int& R, int& C) { const int st = b / 1024, sb = b % 1024, swz = sb ^ (((sb >> 9) & 1) << 5); R = (st >> 1) * 16 + swz / 64; C = (st & 1) * 32 + (swz % 64) / 2; }
__host__ __device__ __forceinline__ int perm32(int rho) { const int n = rho >> 4, i = rho & 15; return 8 * (i >> 2) + 4 * n + (i & 3); }

struct Unit { int pm, pn; };
struct Gemm { const bf16_t* A; const bf16_t* Bt; int M, N, K; };

struct StaticOrder {
    int nM, nN, nwg, G, c;
    __host__ __device__ void init(int M, int N, int G_, int c_) { nM = M / BM; nN = N / BM; nwg = nM * nN; G = G_; c = c_; }
    __host__ __device__ bool next(int i, Unit& u) const {
        const long L = (long)i * G + c; if (L >= nwg) return false;
        int wgid = (int)L; { const int q = nwg / NXCD, r = nwg % NXCD, xcd = wgid % NXCD, off = wgid / NXCD; wgid = (xcd < r ? xcd * (q + 1) : r * (q + 1) + (xcd - r) * q) + off; }
        const int nig = WGM * nN, gid = wgid / nig, fm = gid * WGM, gsz = (nM - fm) < WGM ? (nM - fm) : WGM;
        u.pm = fm + ((wgid % nig) % gsz); u.pn = (wgid % nig) / gsz; return true;
    }
    __device__ __forceinline__ void a_ready(const Unit&) const {}
    __device__ __forceinline__ void done(const Unit&) const {}
};
__device__ __forceinline__ unsigned cvt_pk_bf16(float lo, float hi) { unsigned r; asm volatile("v_cvt_pk_bf16_f32 %0, %1, %2" : "=v"(r) : "v"(lo), "v"(hi)); return r; }
typedef float f32x2 __attribute__((ext_vector_type(2)));
template <class Epi, class Sched, bool ALIGN_EPI = false, bool SP2 = false>
__device__ __forceinline__ void gemm_phase(PG8_LAS unsigned char* lds, const Gemm g, const Sched& S, const Epi& E, const int tid_in) {
    int tid_ = tid_in; asm volatile("" : "+v"(tid_)); const int tid = tid_, wid = __builtin_amdgcn_readfirstlane(tid >> 6), lane = tid & 63, wr = wid >> 2, wc = wid & 3, fr = lane & 15, fq = lane >> 4;
    int K_ = g.K; asm volatile("" : "+s"(K_)); const int K = K_, nt = K / BK;
    unsigned voffA[2], voffB[2];
#pragma unroll
    for (int i = 0; i < 2; ++i) { int R, C; stage_rc(tid * 16 + i * 8192, R, C); const int Rb = Epi::PERM ? ((R & ~31) + perm32(R & 31)) : R;
        voffA[i] = (unsigned)(R * K + C) * 2u; voffB[i] = (unsigned)(Rb * K + C) * 2u; }
    const size_t kstep = (size_t)(BK * 2);
    const size_t hstep = (size_t)HALF * K * 2;
    const size_t tstep = 2 * hstep;
    const unsigned ldsw = (unsigned)wid * 1024u;
    const int aoff = lds_byte(wr * 64 + fr, fq * 8), boff = lds_byte(wc * 32 + fr, fq * 8);
#define PG8_SA(b, h) (((b) * 2 + (h)) * HTB)
#define PG8_SB(b, h) ((4 + (b) * 2 + (h)) * HTB)
#define PG8_STAGE(bufoff, gbase, voff) do { _Pragma("unroll") for (int _i = 0; _i < 2; ++_i) \
        __builtin_amdgcn_global_load_lds((const unsigned*)((const char*)(gbase) + (voff)[_i]), (PG8_LAS unsigned*)(lds + (bufoff) + ldsw + _i * 8192), 16, 0, 0); } while (0)
#define PG8_LDA(dst, b, h) do { _Pragma("unroll") for (int m = 0; m < 4; ++m) _Pragma("unroll") for (int k = 0; k < 2; ++k) dst[m][k] = *(const PG8_LAS bf16x8*)(lds + PG8_SA(b, h) + aoff + m * 2048 + k * 1024); } while (0)
#define PG8_LDB(dst, b, h) do { _Pragma("unroll") for (int n = 0; n < 2; ++n) _Pragma("unroll") for (int k = 0; k < 2; ++k) dst[n][k] = *(const PG8_LAS bf16x8*)(lds + PG8_SB(b, h) + boff + n * 2048 + k * 1024); } while (0)
#define PG8_MMA(ai, bj, At, Bt) do { __builtin_amdgcn_s_setprio(1); _Pragma("unroll") for (int m = 0; m < 4; ++m) _Pragma("unroll") for (int n = 0; n < 2; ++n) _Pragma("unroll") for (int k = 0; k < 2; ++k) \
        acc[ai][bj][m][n] = __builtin_amdgcn_mfma_f32_16x16x32_bf16(Bt[n][k], At[m][k], acc[ai][bj][m][n], 0, 0, 0); __builtin_amdgcn_s_setprio(0); } while (0)
#define PG8_WAIT_V(n) asm volatile("s_waitcnt vmcnt(" #n ")" ::: "memory")
#define PG8_WAIT_L(n) asm volatile("s_waitcnt lgkmcnt(" #n ")" ::: "memory")
#define PG8_BAR __builtin_amdgcn_s_barrier()
#define PG8_SCHED __builtin_amdgcn_sched_barrier(0)
    Unit cur, nxt; int ui = 0;
    if (!S.next(0, cur)) return;
    f32x4 acc[2][2][4][2];
#pragma unroll
    for (int a = 0; a < 2; ++a)
#pragma unroll
        for (int b = 0; b < 2; ++b)
#pragma unroll
            for (int m = 0; m < 4; ++m)
#pragma unroll
                for (int n = 0; n < 2; ++n) acc[a][b][m][n] = (f32x4){0.f, 0.f, 0.f, 0.f};
    bf16x8 At[4][2], B0[2][2], B1[2][2];
    const char* cA = (const char*)g.A + (size_t)cur.pm * tstep; const char* cB = (const char*)g.Bt + (size_t)cur.pn * tstep;
    S.a_ready(cur);
    if constexpr (SP2) {
        PG8_STAGE(PG8_SB(0, 0), cB, voffB); PG8_STAGE(PG8_SB(0, 1), cB + hstep, voffB); PG8_STAGE(PG8_SA(0, 0), cA, voffA); PG8_STAGE(PG8_SA(0, 1), cA + hstep, voffA);
        if (wr == 1) PG8_BAR;
        PG8_WAIT_V(2); PG8_BAR;
        PG8_STAGE(PG8_SB(1, 0), cB + kstep, voffB); PG8_STAGE(PG8_SA(1, 0), cA + kstep, voffA); PG8_STAGE(PG8_SB(1, 1), cB + hstep + kstep, voffB);
        PG8_WAIT_V(6); PG8_BAR;
    } else {
        PG8_STAGE(PG8_SB(0, 0), cB, voffB); PG8_STAGE(PG8_SA(0, 0), cA, voffA); PG8_STAGE(PG8_SB(0, 1), cB + hstep, voffB); PG8_STAGE(PG8_SA(0, 1), cA + hstep, voffA);
        if (wr == 1) PG8_BAR;
        PG8_WAIT_V(4); PG8_BAR;
        PG8_STAGE(PG8_SB(1, 0), cB + kstep, voffB); PG8_STAGE(PG8_SA(1, 0), cA + kstep, voffA); PG8_STAGE(PG8_SB(1, 1), cB + hstep + kstep, voffB);
        PG8_WAIT_V(6); PG8_BAR;
    }
    for (;;) {
        const bool has_next = S.next(ui + 1, nxt);
        const char* nA = has_next ? (const char*)g.A + (size_t)nxt.pm * tstep : cA; const char* nB = has_next ? (const char*)g.Bt + (size_t)nxt.pn * tstep : cB;
        for (int t = 0; t < nt; t += 2) {
            const bool last = (t == nt - 2);
            const char* a1 = cA + (size_t)(t + 1) * kstep;
            const char* a2 = last ? nA : cA + (size_t)(t + 2) * kstep; const char* b2 = last ? nB : cB + (size_t)(t + 2) * kstep;
            const char* a3 = a2 + kstep; const char* b3 = b2 + kstep;
            if (last && has_next) S.a_ready(nxt);
            if constexpr (SP2) {
            PG8_LDB(B0, 0, 0); PG8_LDB(B1, 0, 1); PG8_SCHED; PG8_LDA(At, 0, 0); PG8_STAGE(PG8_SA(1, 1), a1 + hstep, voffA);
            PG8_WAIT_V(8); PG8_WAIT_L(0); PG8_BAR; PG8_MMA(0, 0, At, B0); PG8_MMA(0, 1, At, B1); PG8_BAR; PG8_SCHED;
            PG8_LDA(At, 0, 1); PG8_STAGE(PG8_SB(0, 0), b2, voffB); PG8_STAGE(PG8_SB(0, 1), b2 + hstep, voffB); PG8_STAGE(PG8_SA(0, 0), a2, voffA);
            PG8_WAIT_V(8); PG8_WAIT_L(0); PG8_BAR; PG8_MMA(1, 0, At, B0); PG8_MMA(1, 1, At, B1); PG8_BAR; PG8_SCHED;
            PG8_LDB(B0, 1, 0); PG8_LDB(B1, 1, 1); PG8_SCHED; PG8_LDA(At, 1, 0); PG8_STAGE(PG8_SA(0, 1), a2 + hstep, voffA);
            PG8_WAIT_V(8); PG8_WAIT_L(0); PG8_BAR; PG8_MMA(0, 0, At, B0); PG8_MMA(0, 1, At, B1); PG8_BAR; PG8_SCHED;
            PG8_LDA(At, 1, 1); PG8_STAGE(PG8_SB(1, 0), b3, voffB); PG8_STAGE(PG8_SB(1, 1), b3 + hstep, voffB); PG8_STAGE(PG8_SA(1, 0), a3, voffA);
            PG8_WAIT_V(8); PG8_WAIT_L(0); PG8_BAR; PG8_MMA(1, 0, At, B0); PG8_MMA(1, 1, At, B1); PG8_BAR; PG8_SCHED;
            } else {
            PG8_LDB(B0, 0, 0); PG8_SCHED; PG8_LDA(At, 0, 0); PG8_STAGE(PG8_SA(1, 1), a1 + hstep, voffA);
            PG8_WAIT_L(8); PG8_BAR; PG8_WAIT_L(0); PG8_MMA(0, 0, At, B0); PG8_BAR; PG8_SCHED;
            PG8_LDB(B1, 0, 1); PG8_STAGE(PG8_SB(0, 0), b2, voffB);
            PG8_BAR; PG8_WAIT_L(0); PG8_MMA(0, 1, At, B1); PG8_BAR;
            PG8_LDA(At, 0, 1); PG8_STAGE(PG8_SA(0, 0), a2, voffA);
            PG8_BAR; PG8_WAIT_L(0); PG8_MMA(1, 0, At, B0); PG8_BAR; PG8_SCHED;
            PG8_STAGE(PG8_SB(0, 1), b2 + hstep, voffB);
            PG8_WAIT_V(6); PG8_BAR; PG8_MMA(1, 1, At, B1); PG8_BAR;
            PG8_LDB(B0, 1, 0); PG8_SCHED; PG8_LDA(At, 1, 0); PG8_STAGE(PG8_SA(0, 1), a2 + hstep, voffA);
            PG8_WAIT_L(8); PG8_BAR; PG8_WAIT_L(0); PG8_MMA(0, 0, At, B0); PG8_BAR; PG8_SCHED;
            PG8_LDB(B1, 1, 1); PG8_STAGE(PG8_SB(1, 0), b3, voffB);
            PG8_BAR; PG8_WAIT_L(0); PG8_MMA(0, 1, At, B1); PG8_BAR;
            PG8_LDA(At, 1, 1); PG8_STAGE(PG8_SA(1, 0), a3, voffA);
            PG8_BAR; PG8_WAIT_L(0); PG8_MMA(1, 0, At, B0); PG8_BAR; PG8_SCHED;
            PG8_STAGE(PG8_SB(1, 1), b3 + hstep, voffB);
            PG8_WAIT_V(6); PG8_BAR; PG8_MMA(1, 1, At, B1); PG8_BAR;
            }
        }
        if constexpr (ALIGN_EPI) { if (wr == 0) PG8_BAR; }
        if constexpr (!Epi::AFTER_DRAIN) { E(acc, cur, wr, wc, fr, fq); S.done(cur); }
        if (!has_next) break;
#pragma unroll
        for (int a = 0; a < 2; ++a)
#pragma unroll
            for (int b = 0; b < 2; ++b)
#pragma unroll
                for (int m = 0; m < 4; ++m)
#pragma unroll
                    for (int n = 0; n < 2; ++n) acc[a][b][m][n] = (f32x4){0.f, 0.f, 0.f, 0.f};
        cur = nxt; cA = nA; cB = nB; ++ui;
        if constexpr (ALIGN_EPI) { if (wr == 1) PG8_BAR; }
    }
    PG8_WAIT_V(0);
    if constexpr (!ALIGN_EPI) { if (wr == 0) PG8_BAR; }
    PG8_BAR;
    if constexpr (Epi::AFTER_DRAIN) { E.fused(acc, cur, wr, wc, fr, fq, lds, wid, lane); S.done(cur); }
#undef PG8_SA
#undef PG8_SB
#undef PG8_STAGE
#undef PG8_LDA
#undef PG8_LDB
#undef PG8_MMA
#undef PG8_WAIT_V
#undef PG8_WAIT_L
#undef PG8_BAR
#undef PG8_SCHED
}
}

#define LAS __attribute__((address_space(3)))
using pg8::bf16_t; using pg8::bf16x8; using pg8::f32x4; using pg8::u32x4;
typedef float f32x16 __attribute__((ext_vector_type(16)));
typedef short v4i16_t __attribute__((ext_vector_type(4)));
typedef float f32x2_t __attribute__((ext_vector_type(2)));
typedef __bf16 bf16x2_t __attribute__((ext_vector_type(2)));

constexpr int T = 32768, SEQ = 8192, DM = 1024, DFF = 4096, NLAYER = 2;
constexpr int PW = 2080;
constexpr int PC_QA = 0, PC_KA = 384, PC_VA = 768, PC_QB = 1152, PC_KB = 1408, PC_VB = 1536, PC_CKV = 1664, PC_CQ = 1792, PC_KR = 2048;
constexpr float EPS = 1e-6f, LOG2E = 1.4426950408889634f;
constexpr size_t MiB = 1u << 20;
constexpr size_t WS_CONST = 0, WS_SSP = 1 * MiB, WS_LA = 3 * MiB, WS_W = 6 * MiB, WS_XB = 54 * MiB, WS_ARENA = 118 * MiB;
constexpr size_t WS_U = WS_ARENA, WS_P = WS_ARENA, WS_QC = WS_ARENA + 130 * MiB, WS_KC = WS_ARENA + 166 * MiB, WS_OCAT = WS_ARENA + 202 * MiB,
                 WS_KV = WS_ARENA + 266 * MiB, WS_CQN = WS_ARENA + 314 * MiB, WS_CKVN = WS_ARENA + 330 * MiB, WS_OA = WS_ARENA + 314 * MiB, WS_END = WS_ARENA + 386 * MiB;
static_assert(WS_END <= 512 * MiB, "workspace map");
constexpr size_t WO_IN = 0, WO_UQ = WO_IN + 2304 * 1024, WO_UKV = WO_UQ + 768 * 256, WO_OUT = WO_UKV + 768 * 128, WO_UP = WO_OUT + 1024 * 1024, WO_DN = WO_UP + 4096 * 1024, WO_LAYER = WO_DN + 4096 * 1024;
static_assert(WO_LAYER * 2 * NLAYER <= 48 * MiB, "weights");
constexpr int LDS_BYTES = 131072 + 1024;

__device__ __forceinline__ unsigned cvtpk(float lo, float hi) { f32x2_t v = {lo, hi}; bf16x2_t b = __builtin_convertvector(v, bf16x2_t); return __builtin_bit_cast(unsigned, b); }
__device__ __forceinline__ void unpack8(const u32x4 w, float* v) {
    v[0] = __uint_as_float(w.x << 16); v[1] = __uint_as_float(w.x & 0xffff0000u); v[2] = __uint_as_float(w.y << 16); v[3] = __uint_as_float(w.y & 0xffff0000u);
    v[4] = __uint_as_float(w.z << 16); v[5] = __uint_as_float(w.z & 0xffff0000u); v[6] = __uint_as_float(w.w << 16); v[7] = __uint_as_float(w.w & 0xffff0000u); }
__device__ __forceinline__ u32x4 pack8(const float* v) { u32x4 w; w.x = cvtpk(v[0], v[1]); w.y = cvtpk(v[2], v[3]); w.z = cvtpk(v[4], v[5]); w.w = cvtpk(v[6], v[7]); return w; }
__device__ __forceinline__ float wave_sum(float v) {
#pragma unroll
    for (int o = 1; o < 64; o <<= 1) v += __shfl_xor(v, o);
    return v; }
__device__ __forceinline__ float wave_max(float v) {
#pragma unroll
    for (int o = 1; o < 64; o <<= 1) v = fmaxf(v, __shfl_xor(v, o));
    return v; }

struct Params {
    const float* x; const int* pos; const float* table; const float* norm_mix; const float* w_in; const float* gA; const float* gB; const float* sink;
    const float* qlat; const float* kvlat; const float* w_uq; const float* w_ukv; const float* gC; const float* out_norm; const float* w_out;
    const float* norm_mlp; const float* w_up; const float* w_down;
    float* out; unsigned char* ws; int ph_lo, ph_hi;
};

template <bool SCALE, bool ACT> struct EpiStore {
    static constexpr bool PERM = true, AFTER_DRAIN = false;
    bf16_t* O; int ldc; int ncols; const float* ssp;
    __device__ __forceinline__ void operator()(const f32x4 (&acc)[2][2][4][2], const pg8::Unit& u, int wr, int wc, int fr, int fq) const {
        const int row0 = u.pm * 256 + wr * 64 + fr, col0 = u.pn * 256 + wc * 32 + 8 * fq;
#pragma unroll
        for (int ai = 0; ai < 2; ++ai)
#pragma unroll
            for (int m = 0; m < 4; ++m) {
                const int row = row0 + ai * 128 + m * 16;
                float rs = 1.f;
                if (SCALE) { const f32x4* sp = (const f32x4*)(ssp + (size_t)row * 16); const f32x4 a = sp[0], b = sp[1], c = sp[2], d = sp[3];
                    const float s = ((a[0] + a[1]) + (a[2] + a[3])) + ((b[0] + b[1]) + (b[2] + b[3])) + ((c[0] + c[1]) + (c[2] + c[3])) + ((d[0] + d[1]) + (d[2] + d[3]));
                    rs = rsqrtf(s * (1.f / 1024.f) + EPS); }
                bf16_t* rp = O + (size_t)row * ldc;
#pragma unroll
                for (int bj = 0; bj < 2; ++bj) { const int col = col0 + bj * 128;
                    if (col < ncols) { f32x4 v0 = acc[ai][bj][m][0] * rs, v1 = acc[ai][bj][m][1] * rs;
                        if (ACT) {
#pragma unroll
                            for (int e = 0; e < 4; ++e) { float a0 = fmaxf(v0[e], 0.f), a1 = fmaxf(v1[e], 0.f); v0[e] = a0 * a0; v1[e] = a1 * a1; } }
                        u32x4 w; w.x = cvtpk(v0[0], v0[1]); w.y = cvtpk(v0[2], v0[3]); w.z = cvtpk(v1[0], v1[1]); w.w = cvtpk(v1[2], v1[3]);
                        *(u32x4*)(rp + col) = w; } }
            }
    }
};
struct EpiResid {
    static constexpr bool PERM = true, AFTER_DRAIN = false;
    const float* xin; float* xout; bf16_t* xb; float* ssp;
    __device__ __forceinline__ void operator()(const f32x4 (&acc)[2][2][4][2], const pg8::Unit& u, int wr, int wc, int fr, int fq) const {
        const int row0 = u.pm * 256 + wr * 64 + fr, col0 = u.pn * 256 + wc * 32 + 8 * fq;
#pragma unroll
        for (int ai = 0; ai < 2; ++ai)
#pragma unroll
            for (int m = 0; m < 4; ++m) {
                const int row = row0 + ai * 128 + m * 16; float ss = 0.f;
#pragma unroll
                for (int bj = 0; bj < 2; ++bj) { const size_t off = (size_t)row * DM + col0 + bj * 128;
                    const f32x4 a0 = *(const f32x4*)(xin + off), a1 = *(const f32x4*)(xin + off + 4);
                    const f32x4 v0 = a0 + acc[ai][bj][m][0], v1 = a1 + acc[ai][bj][m][1];
                    *(f32x4*)(xout + off) = v0; *(f32x4*)(xout + off + 4) = v1;
                    ss += (v0[0] * v0[0] + v0[1] * v0[1]) + (v0[2] * v0[2] + v0[3] * v0[3]) + (v1[0] * v1[0] + v1[1] * v1[1]) + (v1[2] * v1[2] + v1[3] * v1[3]);
                    u32x4 w; w.x = cvtpk(v0[0], v0[1]); w.y = cvtpk(v0[2], v0[3]); w.z = cvtpk(v1[0], v1[1]); w.w = cvtpk(v1[2], v1[3]);
                    *(u32x4*)(xb + off) = w; }
                ss += __shfl_xor(ss, 16); ss += __shfl_xor(ss, 32);
                if (fq == 0) ssp[(size_t)row * 16 + u.pn * 4 + wc] = ss;
            }
    }
};

__device__ __forceinline__ void transpose_item(const float* W, int ldw, int c0, const float* gain, bf16_t* WT, int K, int r0, int k0, LAS float* scr, int lane) {
#pragma unroll 8
    for (int i = 0; i < 32; ++i) { const int kk = 2 * i + (lane >> 5); const float g = gain ? gain[k0 + kk] : 1.f; scr[kk * 33 + (lane & 31)] = W[(size_t)(k0 + kk) * ldw + c0 + (lane & 31)] * g; }
    asm volatile("s_waitcnt lgkmcnt(0)" ::: "memory");
    const int c = lane & 7;
#pragma unroll
    for (int j = 0; j < 4; ++j) { const int n = (lane >> 3) + 8 * j; const LAS float* s = scr + (8 * c) * 33 + n;
        u32x4 o; o.x = cvtpk(s[0 * 33], s[1 * 33]); o.y = cvtpk(s[2 * 33], s[3 * 33]); o.z = cvtpk(s[4 * 33], s[5 * 33]); o.w = cvtpk(s[6 * 33], s[7 * 33]);
        *(u32x4*)(WT + (size_t)(r0 + n) * K + k0 + 8 * c) = o; }
    asm volatile("s_waitcnt lgkmcnt(0)" ::: "memory");
}

__device__ __forceinline__ int t5_bucket(int rel) {
    const int n = rel < 0 ? -rel : rel; int v;
    if (n < 8) v = n; else { int far = 8 + (int)(logf((float)n / 8.f) / 4.852030263919617f * 8.f); v = far < 15 ? far : 15; }
    return (rel > 0 ? 16 : 0) + v;
}

__device__ __forceinline__ void phase_prologue(const Params& p, LAS unsigned char* lds, int gw, int NGW, int wave, int lane) {
    LAS float* scr = (LAS float*)(lds + wave * 8448);
    bf16_t* Wb = (bf16_t*)(p.ws + WS_W);
    constexpr int I_IN = 16 * 65, I_UQ = 4 * 18, I_UKV = 2 * 24, I_OUT = 16 * 32, I_UP = 16 * 128, I_DN = 64 * 32, I_L = I_IN + I_UQ + I_UKV + I_OUT + I_UP + I_DN;
    for (int it = gw; it < NLAYER * I_L; it += NGW) {
        const int l = it / I_L; int r = it % I_L; bf16_t* WL = Wb + (size_t)l * WO_LAYER;
        if (r < I_IN) { const int kb = r / 65, blk = r % 65, dc = 32 * blk; const int sc = (dc >= 1664 && dc < 1792) ? dc + 256 : ((dc >= 1792 && dc < 2048) ? dc - 128 : dc);
            transpose_item(p.w_in + (size_t)l * 1024 * 2080, 2080, sc, p.norm_mix + l * 1024, WL + WO_IN, 1024, dc, 64 * kb, scr, lane); continue; } r -= I_IN;
        if (r < I_UQ) { const int kb = r / 18, blk = r % 18; transpose_item(p.w_uq + (size_t)l * 256 * 576, 576, 32 * blk, p.qlat + l * 256, WL + WO_UQ, 256, 32 * blk, 64 * kb, scr, lane); continue; } r -= I_UQ;
        if (r < I_UKV) { const int kb = r / 24, blk = r % 24; transpose_item(p.w_ukv + (size_t)l * 128 * 768, 768, 32 * blk, p.kvlat + l * 128, WL + WO_UKV, 128, 32 * blk, 64 * kb, scr, lane); continue; } r -= I_UKV;
        if (r < I_OUT) { const int kb = r / 32, blk = r % 32; transpose_item(p.w_out + (size_t)l * 1024 * 1024, 1024, 32 * blk, p.out_norm + l * 1024, WL + WO_OUT, 1024, 32 * blk, 64 * kb, scr, lane); continue; } r -= I_OUT;
        if (r < I_UP) { const int kb = r / 128, blk = r % 128; transpose_item(p.w_up + (size_t)l * 1024 * 4096, 4096, 32 * blk, p.norm_mlp + l * 1024, WL + WO_UP, 1024, 32 * blk, 64 * kb, scr, lane); continue; } r -= I_UP;
        { const int kb = r / 32, blk = r % 32; transpose_item(p.w_down + (size_t)l * 4096 * 1024, 1024, 32 * blk, nullptr, WL + WO_DN, 4096, 32 * blk, 64 * kb, scr, lane); }
    }
    bf16_t* XB = (bf16_t*)(p.ws + WS_XB); float* SSP = (float*)(p.ws + WS_SSP);
    for (int row = gw; row < T; row += NGW) {
        const f32x4* xr = (const f32x4*)(p.x + (size_t)row * DM) + lane; float s = 0.f;
        unsigned long long* o8 = (unsigned long long*)(XB + (size_t)row * DM) + lane;
#pragma unroll
        for (int j = 0; j < 4; ++j) { const f32x4 v = xr[64 * j]; s += (v[0] * v[0] + v[1] * v[1]) + (v[2] * v[2] + v[3] * v[3]);
            o8[64 * j] = (unsigned long long)cvtpk(v[0], v[1]) | ((unsigned long long)cvtpk(v[2], v[3]) << 32); }
        s = wave_sum(s);
        if (lane < 16) SSP[(size_t)row * 16 + lane] = lane == 0 ? s : 0.f;
    }
    if (gw == 0) {
        float* C = (float*)(p.ws + WS_CONST);
        float tA = 0.f, tB = 0.f;
        for (int i = lane; i < 320; i += 64) { const float v = fabsf(p.table[i]); if (i % 10 < 6) tA = fmaxf(tA, v); else tB = fmaxf(tB, v); }
        tA = wave_max(tA); tB = wave_max(tB);
        for (int l = 0; l < NLAYER; ++l) {
            const float qa = wave_max(fabsf(p.gA[l * 128 + lane])), ka = wave_max(fabsf(p.gA[l * 128 + 64 + lane]));
            const float qb = wave_max(fabsf(p.gB[l * 128 + lane])), kb = wave_max(fabsf(p.gB[l * 128 + 64 + lane]));
            float qc = fmaxf(fabsf(p.gC[l * 192 + lane]), lane < 32 ? fabsf(p.gC[l * 192 + 64 + lane]) : 0.f); qc = wave_max(qc);
            float kc = fmaxf(fabsf(p.gC[l * 192 + 96 + lane]), lane < 32 ? fabsf(p.gC[l * 192 + 160 + lane]) : 0.f); kc = wave_max(kc);
            float sk = lane < 4 ? p.sink[l * 4 + lane] : -1e30f; sk = wave_max(sk);
            if (lane == 0) { C[l * 8 + 0] = LOG2E * (8.f * qa * ka + tA) + 0.5f;
                             C[l * 8 + 1] = fmaxf(LOG2E * (8.f * qb * kb + tB), LOG2E * sk) + 0.5f;
                             C[l * 8 + 2] = LOG2E * 9.79795897f * qc * kc + 0.5f; }
        }
    }
}

__device__ __forceinline__ void phase_postin(const Params& p, int l, int gw, int NGW, int lane) {
    bf16_t* P = (bf16_t*)(p.ws + WS_P); bf16_t* CQN = (bf16_t*)(p.ws + WS_CQN); bf16_t* CKVN = (bf16_t*)(p.ws + WS_CKVN);
    const float* gA = p.gA + l * 128; const float* gB = p.gB + l * 128;
    for (int row = gw; row < T; row += NGW) {
        bf16_t* pr = P + (size_t)row * PW;
#pragma unroll
        for (int j = 0; j < 4; ++j) {
            const int col = (lane + 64 * j) * 8;
            int type = 0; const float* g = nullptr; float sc = 1.f;
            if (col < PC_KA) { type = 1; g = gA + (col & 63); sc = 0.125f * LOG2E; }
            else if (col < PC_VA) { type = 1; g = gA + 64 + (col & 63); }
            else if (col < PC_QB) { type = 0; }
            else if (col < PC_KB) { type = 1; g = gB + (col & 63); sc = 0.125f * LOG2E; }
            else if (col < PC_VB) { type = 1; g = gB + 64 + (col & 63); }
            else if (col < PC_CKV) { type = 0; }
            else if (col < PC_CQ) { type = 2; }
            else { type = 3; }
            float v[8]; float ss = 0.f;
            if (type) { const u32x4 w = *(const u32x4*)(pr + col); unpack8(w, v);
#pragma unroll
                for (int e = 0; e < 8; ++e) ss += v[e] * v[e]; }
            else {
#pragma unroll
                for (int e = 0; e < 8; ++e) v[e] = 0.f; }
            ss += __shfl_xor(ss, 1); ss += __shfl_xor(ss, 2); ss += __shfl_xor(ss, 4);
            const float s8 = ss; ss += __shfl_xor(ss, 8); const float s16 = ss; ss += __shfl_xor(ss, 16); const float s32 = ss;
            if (type == 1) { const float r = rsqrtf(s8 * (1.f / 64.f) + EPS) * sc; const f32x4 g0 = *(const f32x4*)g, g1 = *(const f32x4*)(g + 4);
#pragma unroll
                for (int e = 0; e < 4; ++e) { v[e] *= r * g0[e]; v[4 + e] *= r * g1[e]; }
                *(u32x4*)(pr + col) = pack8(v); }
            else if (type == 2) { const float r = rsqrtf(s16 * (1.f / 128.f) + EPS);
#pragma unroll
                for (int e = 0; e < 8; ++e) v[e] *= r;
                *(u32x4*)(CKVN + (size_t)row * 128 + (col - PC_CKV)) = pack8(v); }
            else if (type == 3) { const float r = rsqrtf(s32 * (1.f / 256.f) + EPS);
#pragma unroll
                for (int e = 0; e < 8; ++e) v[e] *= r;
                *(u32x4*)(CQN + (size_t)row * 256 + (col - PC_CQ)) = pack8(v); }
        }
    }
}

__device__ __forceinline__ void phase_postlat(const Params& p, int l, int gtid, int nthr) {
    bf16_t* QC = (bf16_t*)(p.ws + WS_QC); bf16_t* KC = (bf16_t*)(p.ws + WS_KC); const bf16_t* KV = (const bf16_t*)(p.ws + WS_KV); const bf16_t* P = (const bf16_t*)(p.ws + WS_P);
#pragma unroll 1
    for (int idx = gtid; idx < T * 12; idx += nthr) {
        const int row = idx / 12, j = idx % 12; const bool isq = j < 6; const int h = isq ? j : j - 6;
        const float* g = p.gC + l * 192 + (isq ? 0 : 96);
        const u32x4* s0 = isq ? (const u32x4*)(QC + (size_t)row * 576 + h * 96) : (const u32x4*)(KV + (size_t)row * 768 + h * 128);
        const u32x4* s1 = isq ? s0 + 8 : (const u32x4*)(P + (size_t)row * PW + PC_KR);
        u32x4* d = (u32x4*)((isq ? QC : KC) + (size_t)row * 576 + h * 96);
        float ss = 0.f; float rp[32];
#pragma unroll
        for (int c = 0; c < 4; ++c) { unpack8(s1[c], rp + 8 * c); }
#pragma unroll
        for (int e = 0; e < 32; ++e) ss += rp[e] * rp[e];
#pragma unroll
        for (int c = 0; c < 8; ++c) { float v[8]; unpack8(s0[c], v);
#pragma unroll
            for (int e = 0; e < 8; ++e) ss += v[e] * v[e]; }
        const float r = rsqrtf(ss * (1.f / 96.f) + EPS);
        const float osc = isq ? 0.10206207261596575f * LOG2E : 1.f;
        const float ro = r * osc;
#pragma unroll
        for (int c = 0; c < 8; ++c) { float v[8]; unpack8(s0[c], v); const f32x4 g0 = *(const f32x4*)(g + 8 * c), g1 = *(const f32x4*)(g + 8 * c + 4);
#pragma unroll
            for (int e = 0; e < 4; ++e) { v[e] *= ro * g0[e]; v[4 + e] *= ro * g1[e]; }
            d[c] = pack8(v); }
#pragma unroll
        for (int c = 0; c < 8; ++c) { const f32x4 gg = *(const f32x4*)(g + 64 + 4 * c);
#pragma unroll
            for (int e = 0; e < 4; ++e) rp[4 * c + e] *= ro * gg[e]; }
        const float fpos = (float)p.pos[row];
#pragma unroll
        for (int i = 0; i < 16; ++i) {
            const float inv = exp2f(-(float)i * (13.287712379549449f / 16.f));
            float rev = fpos * inv * 0.15915494309189535f; rev -= floorf(rev);
            const float sn = __builtin_amdgcn_sinf(rev), cs = __builtin_amdgcn_cosf(rev);
            const float a = rp[i], b = rp[16 + i]; rp[i] = a * cs - b * sn; rp[16 + i] = b * cs + a * sn; }
#pragma unroll
        for (int c = 0; c < 4; ++c) d[8 + c] = pack8(rp + 8 * c);
    }
}

__device__ __forceinline__ int kperm(int m) { return (m & 0x13) | ((m & 4) << 1) | ((m & 8) >> 1); }
__device__ __forceinline__ int crow(int r, int hi) { return (r & 3) + 8 * (r >> 2) + 4 * hi; }
__device__ __forceinline__ v4i16_t vtr(LAS const unsigned char* a) { return __builtin_amdgcn_ds_read_tr16_b64_v4i16((LAS v4i16_t*)a); }
#define MFMA32(a, b, c) __builtin_amdgcn_mfma_f32_32x32x16_bf16((a), (b), (c), 0, 0, 0)

__device__ __forceinline__ void attnC_unit(LAS unsigned char* lds, const bf16_t* __restrict__ Qc, const bf16_t* __restrict__ Kc, const bf16_t* __restrict__ KV, bf16_t* OC, float negMb, int b, int h, int qb, const int tid_in) {
    constexpr int KROW = 208, VROW = 192, KBUF = 64 * KROW, STG = KBUF + 64 * VROW, LSCR = 2 * STG;
    int tid_ = tid_in; asm volatile("" : "+v"(tid_)); const int tid = tid_, lane = tid & 63, wid = tid >> 6, r32 = lane & 31, hi = lane >> 5;
    const size_t rowbase = (size_t)b * SEQ;
    const bf16_t* qp = Qc + (rowbase + qb * 256 + wid * 32 + r32) * 576 + h * 96 + hi * 8;
    bf16x8 qf[6];
#pragma unroll
    for (int kk = 0; kk < 6; ++kk) qf[kk] = *(const bf16x8*)(qp + kk * 16);
    const int c1 = tid + 512; const int k0key = tid / 12, k0part = tid % 12, k1key = c1 / 12, k1part = c1 % 12; const bool has1 = tid < 256;
    const int vkey = tid >> 3, vpart = tid & 7;
    const bf16_t* kg0 = Kc + (rowbase + k0key) * 576 + h * 96 + k0part * 8;
    const bf16_t* kg1 = Kc + (rowbase + k1key) * 576 + h * 96 + k1part * 8;
    const bf16_t* vg = KV + (rowbase + vkey) * 768 + h * 128 + 64 + vpart * 8;
    const int kw0 = k0key * KROW + k0part * 16, kw1 = k1key * KROW + k1part * 16, vw = KBUF + vkey * VROW + vpart * 16;
    const int kra = kperm(r32) * KROW + hi * 16;
    const int g16 = (lane >> 4) & 1, i16 = lane & 15;
    const int vra = KBUF + (8 * hi + (i16 >> 2)) * VROW + (16 * g16 + 4 * (i16 & 3)) * 2;
    f32x16 o0 = {}, o1 = {}; float lsum = 0.f;
    f32x16 negm;
#pragma unroll
    for (int r = 0; r < 16; ++r) negm[r] = negMb;
    u32x4 kr0 = *(const u32x4*)kg0, kr1 = has1 ? *(const u32x4*)kg1 : (u32x4){0, 0, 0, 0}, vr = *(const u32x4*)vg;
    *(LAS u32x4*)(lds + kw0) = kr0; if (has1) *(LAS u32x4*)(lds + kw1) = kr1; *(LAS u32x4*)(lds + vw) = vr;
    __syncthreads();
    constexpr int NT = SEQ / 64;
    for (int t = 0; t < NT; ++t) {
        LAS const unsigned char* cur = lds + (t & 1) * STG;
        if (t + 1 < NT) { const size_t go = (size_t)(t + 1) * 64; kr0 = *(const u32x4*)(kg0 + go * 576); if (has1) kr1 = *(const u32x4*)(kg1 + go * 576); vr = *(const u32x4*)(vg + go * 768); }
        f32x16 s0 = negm, s1 = negm;
#pragma unroll
        for (int kk = 0; kk < 6; ++kk) {
            const bf16x8 a0 = *(LAS const bf16x8*)(cur + kra + kk * 32), a1 = *(LAS const bf16x8*)(cur + kra + 32 * KROW + kk * 32);
            s0 = MFMA32(a0, qf[kk], s0); s1 = MFMA32(a1, qf[kk], s1); }
        float ls = 0.f;
#pragma unroll
        for (int r = 0; r < 16; ++r) { s0[r] = __builtin_amdgcn_exp2f(s0[r]); s1[r] = __builtin_amdgcn_exp2f(s1[r]); ls += s0[r] + s1[r]; }
        lsum += ls;
        u32x4 pa[2][2];
#pragma unroll
        for (int s = 0; s < 2; ++s) {
            pa[0][s] = (u32x4){cvtpk(s0[8 * s], s0[8 * s + 1]), cvtpk(s0[8 * s + 2], s0[8 * s + 3]), cvtpk(s0[8 * s + 4], s0[8 * s + 5]), cvtpk(s0[8 * s + 6], s0[8 * s + 7])};
            pa[1][s] = (u32x4){cvtpk(s1[8 * s], s1[8 * s + 1]), cvtpk(s1[8 * s + 2], s1[8 * s + 3]), cvtpk(s1[8 * s + 4], s1[8 * s + 5]), cvtpk(s1[8 * s + 6], s1[8 * s + 7])}; }
#pragma unroll
        for (int kt = 0; kt < 2; ++kt)
#pragma unroll
            for (int s = 0; s < 2; ++s) {
                LAS const unsigned char* vb = cur + vra + (kt * 32 + 16 * s) * VROW;
                const v4i16_t l0 = vtr(vb), h0 = vtr(vb + 4 * VROW), l1 = vtr(vb + 64), h1 = vtr(vb + 4 * VROW + 64);
                const bf16x8 b0 = {l0[0], l0[1], l0[2], l0[3], h0[0], h0[1], h0[2], h0[3]}, b1 = {l1[0], l1[1], l1[2], l1[3], h1[0], h1[1], h1[2], h1[3]};
                const bf16x8 pf = __builtin_bit_cast(bf16x8, pa[kt][s]);
                o0 = MFMA32(pf, b0, o0); o1 = MFMA32(pf, b1, o1); }
        if (t + 1 < NT) { LAS unsigned char* nx = lds + ((t + 1) & 1) * STG; *(LAS u32x4*)(nx + kw0) = kr0; if (has1) *(LAS u32x4*)(nx + kw1) = kr1; *(LAS u32x4*)(nx + vw) = vr; }
        __syncthreads();
    }
    lsum += __shfl_xor(lsum, 32);
    LAS float* lscr = (LAS float*)(lds + LSCR) + wid * 32;
    if (hi == 0) lscr[r32] = lsum;
    asm volatile("s_waitcnt lgkmcnt(0)" ::: "memory");
    bf16_t* op = OC + (rowbase + qb * 256 + wid * 32) * 1024 + 640 + h * 64 + r32;
#pragma unroll
    for (int r = 0; r < 16; ++r) { const int q = crow(r, hi); const float rl = 1.f / lscr[q];
        op[(size_t)q * 1024] = (bf16_t)(cvtpk(o0[r] * rl, 0.f) & 0xffffu); op[(size_t)q * 1024 + 32] = (bf16_t)(cvtpk(o1[r] * rl, 0.f) & 0xffffu); }
    __syncthreads();
}

template <int R, int NWQ, int MODE>
__device__ __forceinline__ void band_unit(LAS unsigned char* lds, const bf16_t* __restrict__ P, int qcol, int kcol, int vcol, int b, int rho, int rr, int i0, int n,
                                          const float* table, int tcol, float negMb, float sink2, bf16_t* O, int ldo, int ocol, float* L, int lidx, int lstride, const int tid_in) {
    constexpr int NQ = NWQ * 32, NK = NQ + 2 * R, NS = (32 + 2 * R) / 32, ROWB = 144, KS = 0, VS = NK * ROWB, BT = 2 * NK * ROWB, LSC = BT + 1040;
    static_assert(NK == 384, "staging loop assumes 384 keys");
    int tid_ = tid_in; asm volatile("" : "+v"(tid_)); const int tid = tid_, lane = tid & 63, wid = tid >> 6, r32 = lane & 31, hi = lane >> 5;
    const size_t rowbase = (size_t)b * SEQ + rho;
#pragma unroll
    for (int i = 0; i < 6; ++i) { const int c = tid + 512 * i, jj = c >> 3, part = c & 7, j = i0 - R + jj;
        u32x4 kv = {0, 0, 0, 0}, vv = {0, 0, 0, 0};
        if (j >= 0 && j < n) { const bf16_t* rp = P + (rowbase + (size_t)rr * j) * PW + part * 8; kv = *(const u32x4*)(rp + kcol); vv = *(const u32x4*)(rp + vcol); }
        *(LAS u32x4*)(lds + KS + jj * ROWB + part * 16) = kv; *(LAS u32x4*)(lds + VS + jj * ROWB + part * 16) = vv; }
    LAS float* bt = (LAS float*)(lds + BT);
    if (tid < 2 * R + 1) bt[tid] = table[t5_bucket((tid - R) * rr) * 10 + tcol] * LOG2E;
    __syncthreads();
    if (wid < NWQ) {
        const int ql = wid * 32 + r32;
        const bf16_t* qp = P + (rowbase + (size_t)rr * (i0 + ql)) * PW + qcol + hi * 8;
        bf16x8 qf[4];
#pragma unroll
        for (int kk = 0; kk < 4; ++kk) qf[kk] = *(const bf16x8*)(qp + kk * 16);
        f32x16 o0 = {}, o1 = {}; float lsum = 0.f;
        f32x16 negm;
#pragma unroll
        for (int r = 0; r < 16; ++r) negm[r] = negMb;
        const int g16 = (lane >> 4) & 1, i16 = lane & 15;
        const int kra = KS + (wid * 32 + kperm(r32)) * ROWB + hi * 16;
        const int vra = VS + (wid * 32 + 8 * hi + (i16 >> 2)) * ROWB + (16 * g16 + 4 * (i16 & 3)) * 2;
#pragma unroll 1
        for (int kt = 0; kt < NS; ++kt) {
            f32x16 s = negm;
#pragma unroll
            for (int kk = 0; kk < 4; ++kk) { const bf16x8 a = *(LAS const bf16x8*)(lds + kra + kt * 32 * ROWB + kk * 32); s = MFMA32(a, qf[kk], s); }
            float ls = 0.f;
#pragma unroll
            for (int r = 0; r < 16; ++r) {
                const int jj = wid * 32 + kt * 32 + (r & 7) + 8 * hi + 16 * (r >> 3);
                const int rel = jj - R - ql, j = i0 - R + jj;
                const bool ok = (rel >= -R) && (rel <= R) && (j >= 0) && (j < n);
                int bi = rel + R; bi = bi < 0 ? 0 : (bi > 2 * R ? 2 * R : bi);
                const float pv = __builtin_amdgcn_exp2f(s[r] + bt[bi]);
                s[r] = ok ? pv : 0.f; ls += s[r]; }
            lsum += ls;
#pragma unroll
            for (int st = 0; st < 2; ++st) {
                const u32x4 pw = {cvtpk(s[8 * st], s[8 * st + 1]), cvtpk(s[8 * st + 2], s[8 * st + 3]), cvtpk(s[8 * st + 4], s[8 * st + 5]), cvtpk(s[8 * st + 6], s[8 * st + 7])};
                LAS const unsigned char* vb = lds + vra + (kt * 32 + 16 * st) * ROWB;
                const v4i16_t l0 = vtr(vb), h0 = vtr(vb + 4 * ROWB), l1 = vtr(vb + 64), h1 = vtr(vb + 4 * ROWB + 64);
                const bf16x8 b0 = {l0[0], l0[1], l0[2], l0[3], h0[0], h0[1], h0[2], h0[3]}, b1 = {l1[0], l1[1], l1[2], l1[3], h1[0], h1[1], h1[2], h1[3]};
                const bf16x8 pf = __builtin_bit_cast(bf16x8, pw);
                o0 = MFMA32(pf, b0, o0); o1 = MFMA32(pf, b1, o1); }
        }
        lsum += __shfl_xor(lsum, 32);
        if (MODE == 1) lsum += __builtin_amdgcn_exp2f(sink2 + negMb);
        const size_t orow0 = rowbase + (size_t)rr * (i0 + wid * 32);
        if (MODE == 0) {
            if (hi == 0) L[(orow0 + (size_t)rr * r32) * lstride + lidx] = lsum;
            bf16_t* op = O + orow0 * ldo + ocol + r32;
#pragma unroll
            for (int r = 0; r < 16; ++r) { const size_t q = (size_t)rr * crow(r, hi);
                op[q * ldo] = (bf16_t)(cvtpk(o0[r], 0.f) & 0xffffu); op[q * ldo + 32] = (bf16_t)(cvtpk(o1[r], 0.f) & 0xffffu); }
        } else {
            LAS float* lscr = (LAS float*)(lds + LSC) + wid * 32;
            if (hi == 0) lscr[r32] = lsum;
            asm volatile("s_waitcnt lgkmcnt(0)" ::: "memory");
            bf16_t* op = O + orow0 * ldo + ocol + r32;
#pragma unroll
            for (int r = 0; r < 16; ++r) { const int q = crow(r, hi); const float rl = 1.f / lscr[q];
                op[(size_t)q * rr * ldo] = (bf16_t)(cvtpk(o0[r] * rl, 0.f) & 0xffffu); op[(size_t)q * rr * ldo + 32] = (bf16_t)(cvtpk(o1[r] * rl, 0.f) & 0xffffu); }
        }
    }
    __syncthreads();
}

__device__ __forceinline__ void phase_attn(const Params& p, int l, LAS unsigned char* lds, int G, int bx, const int tid) {
    const bf16_t* P = (const bf16_t*)(p.ws + WS_P); const bf16_t* QC = (const bf16_t*)(p.ws + WS_QC); const bf16_t* KC = (const bf16_t*)(p.ws + WS_KC); const bf16_t* KV = (const bf16_t*)(p.ws + WS_KV);
    bf16_t* OCAT = (bf16_t*)(p.ws + WS_OCAT); bf16_t* OA = (bf16_t*)(p.ws + WS_OA); float* LA = (float*)(p.ws + WS_LA);
    const float* C = (const float*)(p.ws + WS_CONST) + l * 8;
    const float mA = C[0], mB = C[1], mC = C[2];
    const int vcu = (G % 8 == 0) ? (bx % 8) * (G / 8) + bx / 8 : bx;
    for (int u = vcu; u < 768; u += G) { const int bh = u >> 5, qb = u & 31; attnC_unit(lds, QC, KC, KV, OCAT, -mC, bh / 6, bh % 6, qb, tid); }
    for (int u = bx; u < 2304 + 1024; u += G) {
        if (u < 2304) { const int cfg = u / 768, rem = u % 768, h = rem / 128, blk = rem % 128; const int rr = cfg == 0 ? 1 : (cfg == 1 ? 4 : 16);
            const int per = 32 / rr, seq = blk / per, ib = blk % per, b = seq / rr, rho = seq % rr;
            band_unit<64, 8, 0>(lds, P, PC_QA + h * 64, PC_KA + h * 64, PC_VA + h * 64, b, rho, rr, ib * 256, SEQ / rr, p.table, h, -mA, 0.f,
                                OA + (size_t)cfg * T * 384, 384, h * 64, LA + (size_t)cfg * T * 6, h, 6, tid); }
        else { const int v = u - 2304, h = v / 256, rem = v % 256, b = rem / 64, ib = rem % 64;
            band_unit<128, 4, 1>(lds, P, PC_QB + h * 64, PC_KB + (h >> 1) * 64, PC_VB + (h >> 1) * 64, b, 0, 1, ib * 128, SEQ, p.table, 6 + h, -mB, p.sink[l * 4 + h] * LOG2E,
                                 OCAT, 1024, 384 + h * 64, nullptr, 0, 0, tid); }
    }
}

__device__ __forceinline__ void phase_merge(const Params& p, int gw, int NGW, int lane) {
    bf16_t* OCAT = (bf16_t*)(p.ws + WS_OCAT); const bf16_t* OA = (const bf16_t*)(p.ws + WS_OA); const float* LA = (const float*)(p.ws + WS_LA);
    for (int row = gw; row < T; row += NGW) {
        float v0[8], v1[8]; float sa = 0.f, sb = 0.f, sc = 0.f;
        const int c0 = lane * 8, c1 = 512 + lane * 8;
        if (c0 < 384) { const int h = c0 >> 6; float a0[8], a1[8], a2[8];
            unpack8(*(const u32x4*)(OA + (size_t)row * 384 + c0), a0); unpack8(*(const u32x4*)(OA + ((size_t)T + row) * 384 + c0), a1); unpack8(*(const u32x4*)(OA + ((size_t)2 * T + row) * 384 + c0), a2);
            const float lt = LA[(size_t)row * 6 + h] + LA[((size_t)T + row) * 6 + h] + LA[((size_t)2 * T + row) * 6 + h]; const float rl = 1.f / lt;
#pragma unroll
            for (int e = 0; e < 8; ++e) { v0[e] = (a0[e] + a1[e] + a2[e]) * rl; sa += v0[e] * v0[e]; } }
        else { unpack8(*(const u32x4*)(OCAT + (size_t)row * 1024 + c0), v0);
#pragma unroll
            for (int e = 0; e < 8; ++e) sb += v0[e] * v0[e]; }
        unpack8(*(const u32x4*)(OCAT + (size_t)row * 1024 + c1), v1);
        { float s = 0.f;
#pragma unroll
            for (int e = 0; e < 8; ++e) s += v1[e] * v1[e];
            if (c1 < 640) sb += s; else sc += s; }
        sa = wave_sum(sa); sb = wave_sum(sb); sc = wave_sum(sc);
        const float ra = rsqrtf(sa * (1.f / 384.f) + EPS), rb = rsqrtf(sb * (1.f / 256.f) + EPS), rc = rsqrtf(sc * (1.f / 384.f) + EPS);
        const float r0 = c0 < 384 ? ra : rb, r1 = c1 < 640 ? rb : rc;
#pragma unroll
        for (int e = 0; e < 8; ++e) { v0[e] *= r0; v1[e] *= r1; }
        *(u32x4*)(OCAT + (size_t)row * 1024 + c0) = pack8(v0); *(u32x4*)(OCAT + (size_t)row * 1024 + c1) = pack8(v1);
    }
}

constexpr int NPHASE = 1 + 10 * NLAYER;
template <int PH> __device__ __forceinline__ void run_phase(const Params& p, LAS unsigned char* lds, const int wave0) {
    int tid_ = threadIdx.x; asm volatile("" : "+v"(tid_)); const int tid = tid_, lane = tid & 63, wave = __builtin_amdgcn_readfirstlane(tid >> 6);
    const int G = gridDim.x, bx = blockIdx.x;
    const int gw = bx * 8 + wave, NGW = G * 8;
    bf16_t* XB = (bf16_t*)(p.ws + WS_XB); float* SSP = (float*)(p.ws + WS_SSP);
    if constexpr (PH == 0) { phase_prologue(p, lds, gw, NGW, wave, lane); }
    else {
        constexpr int l = (PH - 1) / 10, k = (PH - 1) % 10;
        const bf16_t* WL = (const bf16_t*)(p.ws + WS_W) + (size_t)l * WO_LAYER;
        if constexpr (k == 0) {
            pg8::Gemm g{XB, WL + WO_IN, T, 2304, 1024}; pg8::StaticOrder S; S.init(T, 2304, G, bx);
            EpiStore<true, false> E{(bf16_t*)(p.ws + WS_P), PW, PW, SSP};
            pg8::gemm_phase<EpiStore<true, false>, pg8::StaticOrder, true, true>(lds, g, S, E, tid);
        } else if constexpr (k == 1) { phase_postin(p, l, gw, NGW, lane);
        } else if constexpr (k == 2) {
            pg8::Gemm g{(const bf16_t*)(p.ws + WS_CQN), WL + WO_UQ, T, 768, 256}; pg8::StaticOrder S; S.init(T, 768, G, bx);
            EpiStore<false, false> E{(bf16_t*)(p.ws + WS_QC), 576, 576, nullptr};
            pg8::gemm_phase<EpiStore<false, false>, pg8::StaticOrder, true, true>(lds, g, S, E, tid);
        } else if constexpr (k == 9) {
            pg8::Gemm g{(const bf16_t*)(p.ws + WS_CKVN), WL + WO_UKV, T, 768, 128}; pg8::StaticOrder S; S.init(T, 768, G, bx);
            EpiStore<false, false> E{(bf16_t*)(p.ws + WS_KV), 768, 768, nullptr};
            pg8::gemm_phase<EpiStore<false, false>, pg8::StaticOrder, true, true>(lds, g, S, E, tid);
        } else if constexpr (k == 3) { phase_postlat(p, l, bx * 512 + tid, G * 512);
        } else if constexpr (k == 4) { phase_attn(p, l, lds, G, bx, tid);
        } else if constexpr (k == 5) { phase_merge(p, gw, NGW, lane);
        } else if constexpr (k == 6) {
            pg8::Gemm g{(const bf16_t*)(p.ws + WS_OCAT), WL + WO_OUT, T, 1024, 1024}; pg8::StaticOrder S; S.init(T, 1024, G, bx);
            EpiResid E{l == 0 ? p.x : p.out, p.out, XB, SSP};
            pg8::gemm_phase<EpiResid, pg8::StaticOrder, true, true>(lds, g, S, E, tid);
        } else if constexpr (k == 7) {
            pg8::Gemm g{XB, WL + WO_UP, T, 4096, 1024}; pg8::StaticOrder S; S.init(T, 4096, G, bx);
            EpiStore<true, true> E{(bf16_t*)(p.ws + WS_U), 4096, 4096, SSP};
            pg8::gemm_phase<EpiStore<true, true>, pg8::StaticOrder, true, true>(lds, g, S, E, tid);
        } else {
            pg8::Gemm g{(const bf16_t*)(p.ws + WS_U), WL + WO_DN, T, 1024, 4096}; pg8::StaticOrder S; S.init(T, 1024, G, bx);
            EpiResid E{p.out, p.out, XB, SSP};
            pg8::gemm_phase<EpiResid, pg8::StaticOrder, true, true>(lds, g, S, E, tid);
        }
    }
    __syncthreads();
}
#define PHASE(i, PH, SYNC) do { if (lo <= (i) && (i) < hi) { if ((i) > lo && (SYNC)) cg::this_grid().sync(); run_phase<(PH)>(p, lds, wave0); } } while (0)
__global__ void __launch_bounds__(512, 2) fwd_kernel(Params p) {
    extern __shared__ __attribute__((aligned(16))) unsigned char smem[];
    LAS unsigned char* lds = (LAS unsigned char*)smem;
    const int lo = p.ph_lo, hi = p.ph_hi;
    const int wave0 = 0;
    PHASE(0, 0, true);
    PHASE(1, 1, true); PHASE(2, 2, true); PHASE(3, 3, true); PHASE(4, 10, false); PHASE(5, 4, true); PHASE(6, 5, true); PHASE(7, 6, true); PHASE(8, 7, true); PHASE(9, 8, true); PHASE(10, 9, true);
    PHASE(11, 11, true); PHASE(12, 12, true); PHASE(13, 13, true); PHASE(14, 20, false); PHASE(15, 14, true); PHASE(16, 15, true); PHASE(17, 16, true); PHASE(18, 17, true); PHASE(19, 18, true); PHASE(20, 19, true);
}

extern "C" void kernel_launch(void* const* d_in, const int* in_sizes, int n_in, void* d_out, int out_size, void* d_ws, size_t ws_size, hipStream_t stream) {
    static int grid = 0;
    if (grid == 0) {
        if (n_in != 18 || out_size != T * DM || ws_size < WS_END) { fprintf(stderr, "kernel_launch: unexpected shapes (n_in %d out %d ws %zu)\n", n_in, out_size, ws_size); grid = -1; return; }
        int dev = 0, cus = 0, per_cu = 0;
        (void)hipGetDevice(&dev); (void)hipDeviceGetAttribute(&cus, hipDeviceAttributeMultiprocessorCount, dev);
        if (hipFuncSetAttribute((const void*)fwd_kernel, hipFuncAttributeMaxDynamicSharedMemorySize, LDS_BYTES) != hipSuccess) fprintf(stderr, "kernel_launch: hipFuncSetAttribute failed\n");
        if (hipOccupancyMaxActiveBlocksPerMultiprocessor(&per_cu, (const void*)fwd_kernel, 512, LDS_BYTES) != hipSuccess || per_cu < 1) { fprintf(stderr, "kernel_launch: occupancy query says %d\n", per_cu); per_cu = 1; }
        (void)hipGetLastError();
        grid = cus > 0 ? cus : 256;
    }
    if (grid < 0) return;
    Params p{};
    p.x = (const float*)d_in[0]; p.pos = (const int*)d_in[1]; p.table = (const float*)d_in[2]; p.norm_mix = (const float*)d_in[3]; p.w_in = (const float*)d_in[4];
    p.gA = (const float*)d_in[5]; p.gB = (const float*)d_in[6]; p.sink = (const float*)d_in[7]; p.qlat = (const float*)d_in[8]; p.kvlat = (const float*)d_in[9];
    p.w_uq = (const float*)d_in[10]; p.w_ukv = (const float*)d_in[11]; p.gC = (const float*)d_in[12]; p.out_norm = (const float*)d_in[13]; p.w_out = (const float*)d_in[14];
    p.norm_mlp = (const float*)d_in[15]; p.w_up = (const float*)d_in[16]; p.w_down = (const float*)d_in[17];
    p.out = (float*)d_out; p.ws = (unsigned char*)d_ws;
#if MODE_COOP
    p.ph_lo = 0; p.ph_hi = NPHASE;
    void* args[] = {&p};
    hipError_t e = hipLaunchCooperativeKernel((const void*)fwd_kernel, dim3(grid), dim3(512), args, LDS_BYTES, stream);
    if (e != hipSuccess) fprintf(stderr, "kernel_launch: cooperative launch failed: %s\n", hipGetErrorString(e));
#else
    for (int ph = 0; ph < NPHASE; ++ph) { p.ph_lo = ph; p.ph_hi = ph + 1; hipLaunchKernelGGL(fwd_kernel, dim3(grid), dim3(512), LDS_BYTES, stream, p); }
#endif
}
```

```cpp
#include <hip/hip_runtime.h>
#include <hip/hip_cooperative_groups.h>
#include <cstdio>
#include <cstdint>
namespace cg = cooperative_groups;
#ifndef MODE_COOP
#define MODE_COOP 1
#endif
namespace pg8 {
#define PG8_LAS __attribute__((address_space(3)))
typedef unsigned short bf16_t;
typedef short bf16x8 __attribute__((ext_vector_type(8)));
typedef float f32x4 __attribute__((ext_vector_type(4)));
typedef unsigned u32x4 __attribute__((ext_vector_type(4)));
constexpr int BM = 256, BK = 64, HALF = 128, HTB = HALF * BK * 2  , STAGE_BYTES = 8 * HTB, NXCD = 8, WGM = 8;

__host__ __device__ __forceinline__ int lds_byte(int r, int c) { const int st = (r >> 4) * 2 + (c >> 5), rr = r & 15, cc = c & 31, ob = rr * 64 + cc * 2; return st * 1024 + (ob ^ (((ob >> 9) & 1) << 5)); }
__host__ __device__ __forceinline__ void stage_rc(int b, int& R, int& C) { const int st = b / 1024, sb = b % 1024, swz = sb ^ (((sb >> 9) & 1) << 5); R = (st >> 1) * 16 + swz / 64; C = (st & 1) * 32 + (swz % 64) / 2; }
__host__ __device__ __forceinline__ int perm32(int rho) { const int n = rho >> 4, i = rho & 15; return 8 * (i >> 2) + 4 * n + (i & 3); }

struct Unit { int pm, pn; };
struct Gemm { const bf16_t* A; const bf16_t* Bt; int M, N, K; };

struct StaticOrder {
    int nM, nN, nwg, G, c;
    __host__ __device__ void init(int M, int N, int G_, int c_) { nM = M / BM; nN = N / BM; nwg = nM * nN; G = G_; c = c_; }
    __host__ __device__ bool next(int i, Unit& u) const {
        const long L = (long)i * G + c; if (L >= nwg) return false;
        int wgid = (int)L; { const int q = nwg / NXCD, r = nwg % NXCD, xcd = wgid % NXCD, off = wgid / NXCD; wgid = (xcd < r ? xcd * (q + 1) : r * (q + 1) + (xcd - r) * q) + off; }
        const int nig = WGM * nN, gid = wgid / nig, fm = gid * WGM, gsz = (nM - fm) < WGM ? (nM - fm) : WGM;
        u.pm = fm + ((wgid % nig) % gsz); u.pn = (wgid % nig) / gsz; return true;
    }
    __device__ __forceinline__ void a_ready(const Unit&) const {}
    __device__ __forceinline__ void done(const Unit&) const {}
};
__device__ __forceinline__ unsigned cvt_pk_bf16(float lo, float hi) { unsigned r; asm volatile("v_cvt_pk_bf16_f32 %0, %1, %2" : "=v"(r) : "v"(lo), "v"(hi)); return r; }
typedef float f32x2 __attribute__((ext_vector_type(2)));
template <class Epi, class Sched, bool ALIGN_EPI = false, bool SP2 = false>
__device__ __forceinline__ void gemm_phase(PG8_LAS unsigned char* lds, const Gemm g, const Sched& S, const Epi& E, const int tid_in) {
    int tid_ = tid_in; asm volatile("" : "+v"(tid_)); const int tid = tid_, wid = __builtin_amdgcn_readfirstlane(tid >> 6), lane = tid & 63, wr = wid >> 2, wc = wid & 3, fr = lane & 15, fq = lane >> 4;
    int K_ = g.K; asm volatile("" : "+s"(K_)); const int K = K_, nt = K / BK;
    unsigned voffA[2], voffB[2];
#pragma unroll
    for (int i = 0; i < 2; ++i) { int R, C; stage_rc(tid * 16 + i * 8192, R, C); const int Rb = Epi::PERM ? ((R & ~31) + perm32(R & 31)) : R;
        voffA[i] = (unsigned)(R * K + C) * 2u; voffB[i] = (unsigned)(Rb * K + C) * 2u; }
    const size_t kstep = (size_t)(BK * 2);
    const size_t hstep = (size_t)HALF * K * 2;
    const size_t tstep = 2 * hstep;
    const unsigned ldsw = (unsigned)wid * 1024u;
    const int aoff = lds_byte(wr * 64 + fr, fq * 8), boff = lds_byte(wc * 32 + fr, fq * 8);
#define PG8_SA(b, h) (((b) * 2 + (h)) * HTB)
#define PG8_SB(b, h) ((4 + (b) * 2 + (h)) * HTB)
#define PG8_STAGE(bufoff, gbase, voff) do { _Pragma("unroll") for (int _i = 0; _i < 2; ++_i) \
        __builtin_amdgcn_global_load_lds((const unsigned*)((const char*)(gbase) + (voff)[_i]), (PG8_LAS unsigned*)(lds + (bufoff) + ldsw + _i * 8192), 16, 0, 0); } while (0)
#define PG8_LDA(dst, b, h) do { _Pragma("unroll") for (int m = 0; m < 4; ++m) _Pragma("unroll") for (int k = 0; k < 2; ++k) dst[m][k] = *(const PG8_LAS bf16x8*)(lds + PG8_SA(b, h) + aoff + m * 2048 + k * 1024); } while (0)
#define PG8_LDB(dst, b, h) do { _Pragma("unroll") for (int n = 0; n < 2; ++n) _Pragma("unroll") for (int k = 0; k < 2; ++k) dst[n][k] = *(const PG8_LAS bf16x8*)(lds + PG8_SB(b, h) + boff + n * 2048 + k * 1024); } while (0)
#define PG8_MMA(ai, bj, At, Bt) do { __builtin_amdgcn_s_setprio(1); _Pragma("unroll") for (int m = 0; m < 4; ++m) _Pragma("unroll") for (int n = 0; n < 2; ++n) _Pragma("unroll") for (int k = 0; k < 2; ++k) \
        acc[ai][bj][m][n] = __builtin_amdgcn_mfma_f32_16x16x32_bf16(Bt[n][k], At[m][k], acc[ai][bj][m][n], 0, 0, 0); __builtin_amdgcn_s_setprio(0); } while (0)
#define PG8_WAIT_V(n) asm volatile("s_waitcnt vmcnt(" #n ")" ::: "memory")
#define PG8_WAIT_L(n) asm volatile("s_waitcnt lgkmcnt(" #n ")" ::: "memory")
#define PG8_BAR __builtin_amdgcn_s_barrier()
#define PG8_SCHED __builtin_amdgcn_sched_barrier(0)
    Unit cur, nxt; int ui = 0;
    if (!S.next(0, cur)) return;
    f32x4 acc[2][2][4][2];
#pragma unroll
    for (int a = 0; a < 2; ++a)
#pragma unroll
        for (int b = 0; b < 2; ++b)
#pragma unroll
            for (int m = 0; m < 4; ++m)
#pragma unroll
                for (int n = 0; n < 2; ++n) acc[a][b][m][n] = (f32x4){0.f, 0.f, 0.f, 0.f};
    bf16x8 At[4][2], B0[2][2], B1[2][2];
    const char* cA = (const char*)g.A + (size_t)cur.pm * tstep; const char* cB = (const char*)g.Bt + (size_t)cur.pn * tstep;
    S.a_ready(cur);
    if constexpr (SP2) {
        PG8_STAGE(PG8_SB(0, 0), cB, voffB); PG8_STAGE(PG8_SB(0, 1), cB + hstep, voffB); PG8_STAGE(PG8_SA(0, 0), cA, voffA); PG8_STAGE(PG8_SA(0, 1), cA + hstep, voffA);
        if (wr == 1) PG8_BAR;
        PG8_WAIT_V(2); PG8_BAR;
        PG8_STAGE(PG8_SB(1, 0), cB + kstep, voffB); PG8_STAGE(PG8_SA(1, 0), cA + kstep, voffA); PG8_STAGE(PG8_SB(1, 1), cB + hstep + kstep, voffB);
        PG8_WAIT_V(6); PG8_BAR;
    } else {
        PG8_STAGE(PG8_SB(0, 0), cB, voffB); PG8_STAGE(PG8_SA(0, 0), cA, voffA); PG8_STAGE(PG8_SB(0, 1), cB + hstep, voffB); PG8_STAGE(PG8_SA(0, 1), cA + hstep, voffA);
        if (wr == 1) PG8_BAR;
        PG8_WAIT_V(4); PG8_BAR;
        PG8_STAGE(PG8_SB(1, 0), cB + kstep, voffB); PG8_STAGE(PG8_SA(1, 0), cA + kstep, voffA); PG8_STAGE(PG8_SB(1, 1), cB + hstep + kstep, voffB);
        PG8_WAIT_V(6); PG8_BAR;
    }
    for (;;) {
        const bool has_next = S.next(ui + 1, nxt);
        const char* nA = has_next ? (const char*)g.A + (size_t)nxt.pm * tstep : cA; const char* nB = has_next ? (const char*)g.Bt + (size_t)nxt.pn * tstep : cB;
        for (int t = 0; t < nt; t += 2) {
            const bool last = (t == nt - 2);
            const char* a1 = cA + (size_t)(t + 1) * kstep;
            const char* a2 = last ? nA : cA + (size_t)(t + 2) * kstep; const char* b2 = last ? nB : cB + (size_t)(t + 2) * kstep;
            const char* a3 = a2 + kstep; const char* b3 = b2 + kstep;
            if (last && has_next) S.a_ready(nxt);
            if constexpr (SP2) {
            PG8_LDB(B0, 0, 0); PG8_LDB(B1, 0, 1); PG8_SCHED; PG8_LDA(At, 0, 0); PG8_STAGE(PG8_SA(1, 1), a1 + hstep, voffA);
            PG8_WAIT_V(8); PG8_WAIT_L(0); PG8_BAR; PG8_MMA(0, 0, At, B0); PG8_MMA(0, 1, At, B1); PG8_BAR; PG8_SCHED;
            PG8_LDA(At, 0, 1); PG8_STAGE(PG8_SB(0, 0), b2, voffB); PG8_STAGE(PG8_SB(0, 1), b2 + hstep, voffB); PG8_STAGE(PG8_SA(0, 0), a2, voffA);
            PG8_WAIT_V(8); PG8_WAIT_L(0); PG8_BAR; PG8_MMA(1, 0, At, B0); PG8_MMA(1, 1, At, B1); PG8_BAR; PG8_SCHED;
            PG8_LDB(B0, 1, 0); PG8_LDB(B1, 1, 1); PG8_SCHED; PG8_LDA(At, 1, 0); PG8_STAGE(PG8_SA(0, 1), a2 + hstep, voffA);
            PG8_WAIT_V(8); PG8_WAIT_L(0); PG8_BAR; PG8_MMA(0, 0, At, B0); PG8_MMA(0, 1, At, B1); PG8_BAR; PG8_SCHED;
            PG8_LDA(At, 1, 1); PG8_STAGE(PG8_SB(1, 0), b3, voffB); PG8_STAGE(PG8_SB(1, 1), b3 + hstep, voffB); PG8_STAGE(PG8_SA(1, 0), a3, voffA);
            PG8_WAIT_V(8); PG8_WAIT_L(0); PG8_BAR; PG8_MMA(1, 0, At, B0); PG8_MMA(1, 1, At, B1); PG8_BAR; PG8_SCHED;
            } else {
            PG8_LDB(B0, 0, 0); PG8_SCHED; PG8_LDA(At, 0, 0); PG8_STAGE(PG8_SA(1, 1), a1 + hstep, voffA);
            PG8_WAIT_L(8); PG8_BAR; PG8_WAIT_L(0); PG8_MMA(0, 0, At, B0); PG8_BAR; PG8_SCHED;
            PG8_LDB(B1, 0, 1); PG8_STAGE(PG8_SB(0, 0), b2, voffB);
            PG8_BAR; PG8_WAIT_L(0); PG8_MMA(0, 1, At, B1); PG8_BAR;
            PG8_LDA(At, 0, 1); PG8_STAGE(PG8_SA(0, 0), a2, voffA);
            PG8_BAR; PG8_WAIT_L(0); PG8_MMA(1, 0, At, B0); PG8_BAR; PG8_SCHED;
            PG8_STAGE(PG8_SB(0, 1), b2 + hstep, voffB);
            PG8_WAIT_V(6); PG8_BAR; PG8_MMA(1, 1, At, B1); PG8_BAR;
            PG8_LDB(B0, 1, 0); PG8_SCHED; PG8_LDA(At, 1, 0); PG8_STAGE(PG8_SA(0, 1), a2 + hstep, voffA);
            PG8_WAIT_L(8); PG8_BAR; PG8_WAIT_L(0); PG8_MMA(0, 0, At, B0); PG8_BAR; PG8_SCHED;
            PG8_LDB(B1, 1, 1); PG8_STAGE(PG8_SB(1, 0), b3, voffB);
            PG8_BAR; PG8_WAIT_L(0); PG8_MMA(0, 1, At, B1); PG8_BAR;
            PG8_LDA(At, 1, 1); PG8_STAGE(PG8_SA(1, 0), a3, voffA);
            PG8_BAR; PG8_WAIT_L(0); PG8_MMA(1, 0, At, B0); PG8_BAR; PG8_SCHED;
            PG8_STAGE(PG8_SB(1, 1), b3 + hstep, voffB);
            PG8_WAIT_V(6); PG8_BAR; PG8_MMA(1, 1, At, B1); PG8_BAR;
            }
        }
        if constexpr (ALIGN_EPI) { if (wr == 0) PG8_BAR; }
        if constexpr (!Epi::AFTER_DRAIN) { E(acc, cur, wr, wc, fr, fq); S.done(cur); }
        if (!has_next) break;
#pragma unroll
        for (int a = 0; a < 2; ++a)
#pragma unroll
            for (int b = 0; b < 2; ++b)
#pragma unroll
                for (int m = 0; m < 4; ++m)
#pragma unroll
                    for (int n = 0; n < 2; ++n) acc[a][b][m][n] = (f32x4){0.f, 0.f, 0.f, 0.f};
        cur = nxt; cA = nA; cB = nB; ++ui;
        if constexpr (ALIGN_EPI) { if (wr == 1) PG8_BAR; }
    }
    PG8_WAIT_V(0);
    if constexpr (!ALIGN_EPI) { if (wr == 0) PG8_BAR; }
    PG8_BAR;
    if constexpr (Epi::AFTER_DRAIN) { E.fused(acc, cur, wr, wc, fr, fq, lds, wid, lane); S.done(cur); }
#undef PG8_SA
#undef PG8_SB
#undef PG8_STAGE
#undef PG8_LDA
#undef PG8_LDB
#undef PG8_MMA
#undef PG8_WAIT_V
#undef PG8_WAIT_L
#undef PG8_BAR
#undef PG8_SCHED
}
}

#define LAS __attribute__((address_space(3)))
using pg8::bf16_t; using pg8::bf16x8; using pg8::f32x4; using pg8::u32x4;
typedef float f32x16 __attribute__((ext_vector_type(16)));
typedef short v4i16_t __attribute__((ext_vector_type(4)));
typedef float f32x2_t __attribute__((ext_vector_type(2)));
typedef __bf16 bf16x2_t __attribute__((ext_vector_type(2)));

constexpr int T = 32768, SEQ = 8192, DM = 1024, DFF = 4096, NLAYER = 2;
constexpr int PW = 2080;
constexpr int PC_QA = 0, PC_KA = 384, PC_VA = 768, PC_QB = 1152, PC_KB = 1408, PC_VB = 1536, PC_CKV = 1664, PC_CQ = 1792, PC_KR = 2048;
constexpr float EPS = 1e-6f, LOG2E = 1.4426950408889634f;
constexpr size_t MiB = 1u << 20;
constexpr size_t WS_BAR = 4096, WS_BAR_BYTES = 16384;
constexpr size_t WS_CONST = 0, WS_SSP = 1 * MiB, WS_LA = 3 * MiB, WS_W = 6 * MiB, WS_XB = 54 * MiB, WS_ARENA = 118 * MiB;
constexpr size_t WS_U = WS_ARENA, WS_P = WS_ARENA, WS_QC = WS_ARENA + 130 * MiB, WS_KC = WS_ARENA + 166 * MiB, WS_OCAT = WS_ARENA + 202 * MiB,
                 WS_KV = WS_ARENA + 266 * MiB, WS_CQN = WS_ARENA + 314 * MiB, WS_CKVN = WS_ARENA + 330 * MiB, WS_OA = WS_ARENA + 314 * MiB, WS_END = WS_ARENA + 386 * MiB;
static_assert(WS_END <= 512 * MiB, "workspace map");
constexpr size_t WO_IN = 0, WO_UQ = WO_IN + 2304 * 1024, WO_UKV = WO_UQ + 768 * 256, WO_OUT = WO_UKV + 768 * 128, WO_UP = WO_OUT + 1024 * 1024, WO_DN = WO_UP + 4096 * 1024, WO_LAYER = WO_DN + 4096 * 1024;
static_assert(WO_LAYER * 2 * NLAYER <= 48 * MiB, "weights");
constexpr int LDS_BYTES = 131072 + 1024;

__device__ __forceinline__ unsigned cvtpk(float lo, float hi) { f32x2_t v = {lo, hi}; bf16x2_t b = __builtin_convertvector(v, bf16x2_t); return __builtin_bit_cast(unsigned, b); }
__device__ __forceinline__ void unpack8(const u32x4 w, float* v) {
    v[0] = __uint_as_float(w.x << 16); v[1] = __uint_as_float(w.x & 0xffff0000u); v[2] = __uint_as_float(w.y << 16); v[3] = __uint_as_float(w.y & 0xffff0000u);
    v[4] = __uint_as_float(w.z << 16); v[5] = __uint_as_float(w.z & 0xffff0000u); v[6] = __uint_as_float(w.w << 16); v[7] = __uint_as_float(w.w & 0xffff0000u); }
__device__ __forceinline__ u32x4 pack8(const float* v) { u32x4 w; w.x = cvtpk(v[0], v[1]); w.y = cvtpk(v[2], v[3]); w.z = cvtpk(v[4], v[5]); w.w = cvtpk(v[6], v[7]); return w; }
__device__ __forceinline__ float wave_sum(float v) {
#pragma unroll
    for (int o = 1; o < 64; o <<= 1) v += __shfl_xor(v, o);
    return v; }
__device__ __forceinline__ float wave_max(float v) {
#pragma unroll
    for (int o = 1; o < 64; o <<= 1) v = fmaxf(v, __shfl_xor(v, o));
    return v; }

struct Params {
    const float* x; const int* pos; const float* table; const float* norm_mix; const float* w_in; const float* gA; const float* gB; const float* sink;
    const float* qlat; const float* kvlat; const float* w_uq; const float* w_ukv; const float* gC; const float* out_norm; const float* w_out;
    const float* norm_mlp; const float* w_up; const float* w_down;
    float* out; unsigned char* ws; int ph_lo, ph_hi;
};

template <bool SCALE, bool ACT> struct EpiStore {
    static constexpr bool PERM = true, AFTER_DRAIN = false;
    bf16_t* O; int ldc; int ncols; const float* ssp;
    __device__ __forceinline__ void operator()(const f32x4 (&acc)[2][2][4][2], const pg8::Unit& u, int wr, int wc, int fr, int fq) const {
        const int row0 = u.pm * 256 + wr * 64 + fr, col0 = u.pn * 256 + wc * 32 + 8 * fq;
#pragma unroll
        for (int ai = 0; ai < 2; ++ai)
#pragma unroll
            for (int m = 0; m < 4; ++m) {
                const int row = row0 + ai * 128 + m * 16;
                float rs = 1.f;
                if (SCALE) { const f32x4* sp = (const f32x4*)(ssp + (size_t)row * 16); const f32x4 a = sp[0], b = sp[1], c = sp[2], d = sp[3];
                    const float s = ((a[0] + a[1]) + (a[2] + a[3])) + ((b[0] + b[1]) + (b[2] + b[3])) + ((c[0] + c[1]) + (c[2] + c[3])) + ((d[0] + d[1]) + (d[2] + d[3]));
                    rs = rsqrtf(s * (1.f / 1024.f) + EPS); }
                bf16_t* rp = O + (size_t)row * ldc;
#pragma unroll
                for (int bj = 0; bj < 2; ++bj) { const int col = col0 + bj * 128;
                    if (col < ncols) { f32x4 v0 = acc[ai][bj][m][0] * rs, v1 = acc[ai][bj][m][1] * rs;
                        if (ACT) {
#pragma unroll
                            for (int e = 0; e < 4; ++e) { float a0 = fmaxf(v0[e], 0.f), a1 = fmaxf(v1[e], 0.f); v0[e] = a0 * a0; v1[e] = a1 * a1; } }
                        u32x4 w; w.x = cvtpk(v0[0], v0[1]); w.y = cvtpk(v0[2], v0[3]); w.z = cvtpk(v1[0], v1[1]); w.w = cvtpk(v1[2], v1[3]);
                        *(u32x4*)(rp + col) = w; } }
            }
    }
};
struct EpiResid {
    static constexpr bool PERM = true, AFTER_DRAIN = false;
    const float* xin; float* xout; bf16_t* xb; float* ssp;
    __device__ __forceinline__ void operator()(const f32x4 (&acc)[2][2][4][2], const pg8::Unit& u, int wr, int wc, int fr, int fq) const {
        const int row0 = u.pm * 256 + wr * 64 + fr, col0 = u.pn * 256 + wc * 32 + 8 * fq;
#pragma unroll
        for (int ai = 0; ai < 2; ++ai)
#pragma unroll
            for (int m = 0; m < 4; ++m) {
                const int row = row0 + ai * 128 + m * 16; float ss = 0.f;
#pragma unroll
                for (int bj = 0; bj < 2; ++bj) { const size_t off = (size_t)row * DM + col0 + bj * 128;
                    const f32x4 a0 = *(const f32x4*)(xin + off), a1 = *(const f32x4*)(xin + off + 4);
                    const f32x4 v0 = a0 + acc[ai][bj][m][0], v1 = a1 + acc[ai][bj][m][1];
                    *(f32x4*)(xout + off) = v0; *(f32x4*)(xout + off + 4) = v1;
                    ss += (v0[0] * v0[0] + v0[1] * v0[1]) + (v0[2] * v0[2] + v0[3] * v0[3]) + (v1[0] * v1[0] + v1[1] * v1[1]) + (v1[2] * v1[2] + v1[3] * v1[3]);
                    u32x4 w; w.x = cvtpk(v0[0], v0[1]); w.y = cvtpk(v0[2], v0[3]); w.z = cvtpk(v1[0], v1[1]); w.w = cvtpk(v1[2], v1[3]);
                    *(u32x4*)(xb + off) = w; }
                ss += __shfl_xor(ss, 16); ss += __shfl_xor(ss, 32);
                if (fq == 0) ssp[(size_t)row * 16 + u.pn * 4 + wc] = ss;
            }
    }
};

__device__ __forceinline__ void transpose_item(const float* W, int ldw, int c0, const float* gain, bf16_t* WT, int K, int r0, int k0, LAS float* scr, int lane) {
#pragma unroll 8
    for (int i = 0; i < 32; ++i) { const int kk = 2 * i + (lane >> 5); const float g = gain ? gain[k0 + kk] : 1.f; scr[kk * 33 + (lane & 31)] = W[(size_t)(k0 + kk) * ldw + c0 + (lane & 31)] * g; }
    asm volatile("s_waitcnt lgkmcnt(0)" ::: "memory");
    const int c = lane & 7;
#pragma unroll
    for (int j = 0; j < 4; ++j) { const int n = (lane >> 3) + 8 * j; const LAS float* s = scr + (8 * c) * 33 + n;
        u32x4 o; o.x = cvtpk(s[0 * 33], s[1 * 33]); o.y = cvtpk(s[2 * 33], s[3 * 33]); o.z = cvtpk(s[4 * 33], s[5 * 33]); o.w = cvtpk(s[6 * 33], s[7 * 33]);
        *(u32x4*)(WT + (size_t)(r0 + n) * K + k0 + 8 * c) = o; }
    asm volatile("s_waitcnt lgkmcnt(0)" ::: "memory");
}

__device__ __forceinline__ int t5_bucket(int rel) {
    const int n = rel < 0 ? -rel : rel; int v;
    if (n < 8) v = n; else { int far = 8 + (int)(logf((float)n / 8.f) / 4.852030263919617f * 8.f); v = far < 15 ? far : 15; }
    return (rel > 0 ? 16 : 0) + v;
}

__device__ __forceinline__ void phase_prologue(const Params& p, LAS unsigned char* lds, int gw, int NGW, int wave, int lane) {
    LAS float* scr = (LAS float*)(lds + wave * 8448);
    bf16_t* Wb = (bf16_t*)(p.ws + WS_W);
    constexpr int I_IN = 16 * 65, I_UQ = 4 * 18, I_UKV = 2 * 24, I_OUT = 16 * 32, I_UP = 16 * 128, I_DN = 64 * 32, I_L = I_IN + I_UQ + I_UKV + I_OUT + I_UP + I_DN;
    for (int it = gw; it < NLAYER * I_L; it += NGW) {
        const int l = it / I_L; int r = it % I_L; bf16_t* WL = Wb + (size_t)l * WO_LAYER;
        if (r < I_IN) { const int kb = r / 65, blk = r % 65, dc = 32 * blk; const int sc = (dc >= 1664 && dc < 1792) ? dc + 256 : ((dc >= 1792 && dc < 2048) ? dc - 128 : dc);
            transpose_item(p.w_in + (size_t)l * 1024 * 2080, 2080, sc, p.norm_mix + l * 1024, WL + WO_IN, 1024, dc, 64 * kb, scr, lane); continue; } r -= I_IN;
        if (r < I_UQ) { const int kb = r / 18, blk = r % 18; transpose_item(p.w_uq + (size_t)l * 256 * 576, 576, 32 * blk, p.qlat + l * 256, WL + WO_UQ, 256, 32 * blk, 64 * kb, scr, lane); continue; } r -= I_UQ;
        if (r < I_UKV) { const int kb = r / 24, blk = r % 24; transpose_item(p.w_ukv + (size_t)l * 128 * 768, 768, 32 * blk, p.kvlat + l * 128, WL + WO_UKV, 128, 32 * blk, 64 * kb, scr, lane); continue; } r -= I_UKV;
        if (r < I_OUT) { const int kb = r / 32, blk = r % 32; transpose_item(p.w_out + (size_t)l * 1024 * 1024, 1024, 32 * blk, p.out_norm + l * 1024, WL + WO_OUT, 1024, 32 * blk, 64 * kb, scr, lane); continue; } r -= I_OUT;
        if (r < I_UP) { const int kb = r / 128, blk = r % 128; transpose_item(p.w_up + (size_t)l * 1024 * 4096, 4096, 32 * blk, p.norm_mlp + l * 1024, WL + WO_UP, 1024, 32 * blk, 64 * kb, scr, lane); continue; } r -= I_UP;
        { const int kb = r / 32, blk = r % 32; transpose_item(p.w_down + (size_t)l * 4096 * 1024, 1024, 32 * blk, nullptr, WL + WO_DN, 4096, 32 * blk, 64 * kb, scr, lane); }
    }
    bf16_t* XB = (bf16_t*)(p.ws + WS_XB); float* SSP = (float*)(p.ws + WS_SSP);
    for (int row = gw; row < T; row += NGW) {
        const f32x4* xr = (const f32x4*)(p.x + (size_t)row * DM) + lane; float s = 0.f;
        unsigned long long* o8 = (unsigned long long*)(XB + (size_t)row * DM) + lane;
#pragma unroll
        for (int j = 0; j < 4; ++j) { const f32x4 v = xr[64 * j]; s += (v[0] * v[0] + v[1] * v[1]) + (v[2] * v[2] + v[3] * v[3]);
            o8[64 * j] = (unsigned long long)cvtpk(v[0], v[1]) | ((unsigned long long)cvtpk(v[2], v[3]) << 32); }
        s = wave_sum(s);
        if (lane < 16) SSP[(size_t)row * 16 + lane] = lane == 0 ? s : 0.f;
    }
    if (gw == 0) {
        float* C = (float*)(p.ws + WS_CONST);
        float tA = 0.f, tB = 0.f;
        for (int i = lane; i < 320; i += 64) { const float v = fabsf(p.table[i]); if (i % 10 < 6) tA = fmaxf(tA, v); else tB = fmaxf(tB, v); }
        tA = wave_max(tA); tB = wave_max(tB);
        for (int l = 0; l < NLAYER; ++l) {
            const float qa = wave_max(fabsf(p.gA[l * 128 + lane])), ka = wave_max(fabsf(p.gA[l * 128 + 64 + lane]));
            const float qb = wave_max(fabsf(p.gB[l * 128 + lane])), kb = wave_max(fabsf(p.gB[l * 128 + 64 + lane]));
            float qc = fmaxf(fabsf(p.gC[l * 192 + lane]), lane < 32 ? fabsf(p.gC[l * 192 + 64 + lane]) : 0.f); qc = wave_max(qc);
            float kc = fmaxf(fabsf(p.gC[l * 192 + 96 + lane]), lane < 32 ? fabsf(p.gC[l * 192 + 160 + lane]) : 0.f); kc = wave_max(kc);
            float sk = lane < 4 ? p.sink[l * 4 + lane] : -1e30f; sk = wave_max(sk);
            if (lane == 0) { C[l * 8 + 0] = LOG2E * (8.f * qa * ka + tA) + 0.5f;
                             C[l * 8 + 1] = fmaxf(LOG2E * (8.f * qb * kb + tB), LOG2E * sk) + 0.5f;
                             C[l * 8 + 2] = LOG2E * 9.79795897f * qc * kc + 0.5f; }
        }
    }
}

__device__ __forceinline__ void phase_postin(const Params& p, int l, int gw, int NGW, int lane) {
    bf16_t* P = (bf16_t*)(p.ws + WS_P); bf16_t* CQN = (bf16_t*)(p.ws + WS_CQN); bf16_t* CKVN = (bf16_t*)(p.ws + WS_CKVN);
    const float* gA = p.gA + l * 128; const float* gB = p.gB + l * 128;
    for (int row = gw; row < T; row += NGW) {
        bf16_t* pr = P + (size_t)row * PW;
#pragma unroll
        for (int j = 0; j < 4; ++j) {
            const int col = (lane + 64 * j) * 8;
            int type = 0; const float* g = nullptr; float sc = 1.f;
            if (col < PC_KA) { type = 1; g = gA + (col & 63); sc = 0.125f * LOG2E; }
            else if (col < PC_VA) { type = 1; g = gA + 64 + (col & 63); }
            else if (col < PC_QB) { type = 0; }
            else if (col < PC_KB) { type = 1; g = gB + (col & 63); sc = 0.125f * LOG2E; }
            else if (col < PC_VB) { type = 1; g = gB + 64 + (col & 63); }
            else if (col < PC_CKV) { type = 0; }
            else if (col < PC_CQ) { type = 2; }
            else { type = 3; }
            float v[8]; float ss = 0.f;
            if (type) { const u32x4 w = *(const u32x4*)(pr + col); unpack8(w, v);
#pragma unroll
                for (int e = 0; e < 8; ++e) ss += v[e] * v[e]; }
            else {
#pragma unroll
                for (int e = 0; e < 8; ++e) v[e] = 0.f; }
            ss += __shfl_xor(ss, 1); ss += __shfl_xor(ss, 2); ss += __shfl_xor(ss, 4);
            const float s8 = ss; ss += __shfl_xor(ss, 8); const float s16 = ss; ss += __shfl_xor(ss, 16); const float s32 = ss;
            if (type == 1) { const float r = rsqrtf(s8 * (1.f / 64.f) + EPS) * sc; const f32x4 g0 = *(const f32x4*)g, g1 = *(const f32x4*)(g + 4);
#pragma unroll
                for (int e = 0; e < 4; ++e) { v[e] *= r * g0[e]; v[4 + e] *= r * g1[e]; }
                *(u32x4*)(pr + col) = pack8(v); }
            else if (type == 2) { const float r = rsqrtf(s16 * (1.f / 128.f) + EPS);
#pragma unroll
                for (int e = 0; e < 8; ++e) v[e] *= r;
                *(u32x4*)(CKVN + (size_t)row * 128 + (col - PC_CKV)) = pack8(v); }
            else if (type == 3) { const float r = rsqrtf(s32 * (1.f / 256.f) + EPS);
#pragma unroll
                for (int e = 0; e < 8; ++e) v[e] *= r;
                *(u32x4*)(CQN + (size_t)row * 256 + (col - PC_CQ)) = pack8(v); }
        }
    }
}

__device__ __forceinline__ void phase_postlat(const Params& p, int l, int gtid, int nthr) {
    bf16_t* QC = (bf16_t*)(p.ws + WS_QC); bf16_t* KC = (bf16_t*)(p.ws + WS_KC); const bf16_t* KV = (const bf16_t*)(p.ws + WS_KV); const bf16_t* P = (const bf16_t*)(p.ws + WS_P);
#pragma unroll 1
    for (int idx = gtid; idx < T * 12; idx += nthr) {
        const int row = idx / 12, j = idx % 12; const bool isq = j < 6; const int h = isq ? j : j - 6;
        const float* g = p.gC + l * 192 + (isq ? 0 : 96);
        const u32x4* s0 = isq ? (const u32x4*)(QC + (size_t)row * 576 + h * 96) : (const u32x4*)(KV + (size_t)row * 768 + h * 128);
        const u32x4* s1 = isq ? s0 + 8 : (const u32x4*)(P + (size_t)row * PW + PC_KR);
        u32x4* d = (u32x4*)((isq ? QC : KC) + (size_t)row * 576 + h * 96);
        float ss = 0.f; float rp[32];
#pragma unroll
        for (int c = 0; c < 4; ++c) { unpack8(s1[c], rp + 8 * c); }
#pragma unroll
        for (int e = 0; e < 32; ++e) ss += rp[e] * rp[e];
#pragma unroll
        for (int c = 0; c < 8; ++c) { float v[8]; unpack8(s0[c], v);
#pragma unroll
            for (int e = 0; e < 8; ++e) ss += v[e] * v[e]; }
        const float r = rsqrtf(ss * (1.f / 96.f) + EPS);
        const float osc = isq ? 0.10206207261596575f * LOG2E : 1.f;
        const float ro = r * osc;
#pragma unroll
        for (int c = 0; c < 8; ++c) { float v[8]; unpack8(s0[c], v); const f32x4 g0 = *(const f32x4*)(g + 8 * c), g1 = *(const f32x4*)(g + 8 * c + 4);
#pragma unroll
            for (int e = 0; e < 4; ++e) { v[e] *= ro * g0[e]; v[4 + e] *= ro * g1[e]; }
            d[c] = pack8(v); }
#pragma unroll
        for (int c = 0; c < 8; ++c) { const f32x4 gg = *(const f32x4*)(g + 64 + 4 * c);
#pragma unroll
            for (int e = 0; e < 4; ++e) rp[4 * c + e] *= ro * gg[e]; }
        const float fpos = (float)p.pos[row];
#pragma unroll
        for (int i = 0; i < 16; ++i) {
            const float inv = exp2f(-(float)i * (13.287712379549449f / 16.f));
            float rev = fpos * inv * 0.15915494309189535f; rev -= floorf(rev);
            const float sn = __builtin_amdgcn_sinf(rev), cs = __builtin_amdgcn_cosf(rev);
            const float a = rp[i], b = rp[16 + i]; rp[i] = a * cs - b * sn; rp[16 + i] = b * cs + a * sn; }
#pragma unroll
        for (int c = 0; c < 4; ++c) d[8 + c] = pack8(rp + 8 * c);
    }
}

__device__ __forceinline__ int kperm(int m) { return (m & 0x13) | ((m & 4) << 1) | ((m & 8) >> 1); }
__device__ __forceinline__ int crow(int r, int hi) { return (r & 3) + 8 * (r >> 2) + 4 * hi; }
__device__ __forceinline__ v4i16_t vtr(LAS const unsigned char* a) { return __builtin_amdgcn_ds_read_tr16_b64_v4i16((LAS v4i16_t*)a); }
#define MFMA32(a, b, c) __builtin_amdgcn_mfma_f32_32x32x16_bf16((a), (b), (c), 0, 0, 0)

__device__ __forceinline__ void attnC_unit(LAS unsigned char* lds, const bf16_t* __restrict__ Qc, const bf16_t* __restrict__ Kc, const bf16_t* __restrict__ KV, bf16_t* OC, float negMb, int b, int h, int qb, const int tid_in) {
    constexpr int KROW = 208, VROW = 192, KBUF = 64 * KROW, STG = KBUF + 64 * VROW, XL = 4 * STG, LSCR = XL + 1024;
    int tid_ = tid_in; asm volatile("" : "+v"(tid_)); const int tid = tid_, lane = tid & 63, wid = tid >> 6, r32 = lane & 31, hi = lane >> 5;
    const int grp = wid >> 2, wq = wid & 3, gt = tid & 255;
    const size_t rowbase = (size_t)b * SEQ;
    const bf16_t* qp = Qc + (rowbase + qb * 256 + wq * 64 + r32) * 576 + h * 96 + hi * 8;
    bf16x8 qf[2][6];
#pragma unroll
    for (int qt = 0; qt < 2; ++qt)
#pragma unroll
        for (int kk = 0; kk < 6; ++kk) qf[qt][kk] = *(const bf16x8*)(qp + (size_t)qt * 32 * 576 + kk * 16);
    const size_t key0 = rowbase + (size_t)grp * (SEQ / 2);
    unsigned kg[3]; int kw[3]; unsigned vg[2]; int vw[2];
    const bf16_t* Kb = Kc + key0 * 576 + h * 96; const bf16_t* Vb = KV + key0 * 768 + h * 128 + 64;
#pragma unroll
    for (int i = 0; i < 3; ++i) { const int c = gt + 256 * i, key = c / 12, part = c % 12; kg[i] = (unsigned)(key * 576 + part * 8); kw[i] = key * KROW + part * 16; }
#pragma unroll
    for (int i = 0; i < 2; ++i) { const int c = gt + 256 * i, key = c >> 3, part = c & 7; vg[i] = (unsigned)(key * 768 + part * 8); vw[i] = KBUF + key * VROW + part * 16; }
    LAS unsigned char* gl = lds + grp * 2 * STG;
    const int kra = kperm(r32) * KROW + hi * 16;
    const int g16 = (lane >> 4) & 1, i16 = lane & 15;
    const int vra = KBUF + (8 * hi + (i16 >> 2)) * VROW + (16 * g16 + 4 * (i16 & 3)) * 2;
    f32x16 o00 = {}, o01 = {}, o10 = {}, o11 = {}; float ls0 = 0.f, ls1 = 0.f;
    f32x16 negm;
#pragma unroll
    for (int r = 0; r < 16; ++r) negm[r] = negMb;
    u32x4 kr[3], vr[2];
#pragma unroll
    for (int i = 0; i < 3; ++i) kr[i] = *(const u32x4*)(Kb + kg[i]);
#pragma unroll
    for (int i = 0; i < 2; ++i) vr[i] = *(const u32x4*)(Vb + vg[i]);
#pragma unroll
    for (int i = 0; i < 3; ++i) *(LAS u32x4*)(gl + kw[i]) = kr[i];
#pragma unroll
    for (int i = 0; i < 2; ++i) *(LAS u32x4*)(gl + vw[i]) = vr[i];
    __syncthreads();
    constexpr int NT = SEQ / 128;
#pragma unroll 1
    for (int t = 0; t < NT; ++t) {
        LAS const unsigned char* cur = gl + (t & 1) * STG;
        if (t + 1 < NT) { const size_t go = (size_t)(t + 1) * 64;
#pragma unroll
            for (int i = 0; i < 3; ++i) kr[i] = *(const u32x4*)(Kb + go * 576 + kg[i]);
#pragma unroll
            for (int i = 0; i < 2; ++i) vr[i] = *(const u32x4*)(Vb + go * 768 + vg[i]); }
#pragma unroll 1
        for (int kt = 0; kt < 2; ++kt) {
            f32x16 s0 = negm, s1 = negm;
#pragma unroll
            for (int kk = 0; kk < 6; ++kk) { const bf16x8 a = *(LAS const bf16x8*)(cur + kra + kt * 32 * KROW + kk * 32); s0 = MFMA32(a, qf[0][kk], s0); s1 = MFMA32(a, qf[1][kk], s1); }
            float a0 = 0.f, a1 = 0.f;
#pragma unroll
            for (int r = 0; r < 16; ++r) { s0[r] = __builtin_amdgcn_exp2f(s0[r]); s1[r] = __builtin_amdgcn_exp2f(s1[r]); a0 += s0[r]; a1 += s1[r]; }
            ls0 += a0; ls1 += a1;
#pragma unroll
            for (int st = 0; st < 2; ++st) {
                const u32x4 p0 = {cvtpk(s0[8 * st], s0[8 * st + 1]), cvtpk(s0[8 * st + 2], s0[8 * st + 3]), cvtpk(s0[8 * st + 4], s0[8 * st + 5]), cvtpk(s0[8 * st + 6], s0[8 * st + 7])};
                const u32x4 p1 = {cvtpk(s1[8 * st], s1[8 * st + 1]), cvtpk(s1[8 * st + 2], s1[8 * st + 3]), cvtpk(s1[8 * st + 4], s1[8 * st + 5]), cvtpk(s1[8 * st + 6], s1[8 * st + 7])};
                LAS const unsigned char* vb = cur + vra + (kt * 32 + 16 * st) * VROW;
                const v4i16_t l0 = vtr(vb), h0 = vtr(vb + 4 * VROW), l1 = vtr(vb + 64), h1 = vtr(vb + 4 * VROW + 64);
                const bf16x8 b0 = {l0[0], l0[1], l0[2], l0[3], h0[0], h0[1], h0[2], h0[3]}, b1 = {l1[0], l1[1], l1[2], l1[3], h1[0], h1[1], h1[2], h1[3]};
                const bf16x8 pf0 = __builtin_bit_cast(bf16x8, p0), pf1 = __builtin_bit_cast(bf16x8, p1);
                o00 = MFMA32(pf0, b0, o00); o01 = MFMA32(pf0, b1, o01); o10 = MFMA32(pf1, b0, o10); o11 = MFMA32(pf1, b1, o11); }
        }
        if (t + 1 < NT) { LAS unsigned char* nx = gl + ((t + 1) & 1) * STG;
#pragma unroll
            for (int i = 0; i < 3; ++i) *(LAS u32x4*)(nx + kw[i]) = kr[i];
#pragma unroll
            for (int i = 0; i < 2; ++i) *(LAS u32x4*)(nx + vw[i]) = vr[i]; }
        __syncthreads();
    }
    ls0 += __shfl_xor(ls0, 32); ls1 += __shfl_xor(ls1, 32);
    LAS float* xo = (LAS float*)lds + (size_t)wq * 4096 + lane;
    LAS float* xl = (LAS float*)(lds + XL) + wq * 64;
    if (grp == 1) {
#pragma unroll
        for (int r = 0; r < 16; ++r) { xo[(0 + r) * 64] = o00[r]; xo[(16 + r) * 64] = o01[r]; xo[(32 + r) * 64] = o10[r]; xo[(48 + r) * 64] = o11[r]; }
        if (hi == 0) { xl[r32] = ls0; xl[32 + r32] = ls1; }
    }
    __syncthreads();
    if (grp == 0) {
#pragma unroll
        for (int r = 0; r < 16; ++r) { o00[r] += xo[(0 + r) * 64]; o01[r] += xo[(16 + r) * 64]; o10[r] += xo[(32 + r) * 64]; o11[r] += xo[(48 + r) * 64]; }
        ls0 += xl[r32]; ls1 += xl[32 + r32];
        LAS float* lscr = (LAS float*)(lds + LSCR) + wq * 64;
        if (hi == 0) { lscr[r32] = ls0; lscr[32 + r32] = ls1; }
        asm volatile("s_waitcnt lgkmcnt(0)" ::: "memory");
        bf16_t* op = OC + (rowbase + qb * 256 + wq * 64) * 1024 + 640 + h * 64 + r32;
#pragma unroll
        for (int r = 0; r < 16; ++r) { const int q = crow(r, hi); const float rl0 = 1.f / lscr[q], rl1 = 1.f / lscr[32 + q];
            op[(size_t)q * 1024] = (bf16_t)(cvtpk(o00[r] * rl0, 0.f) & 0xffffu); op[(size_t)q * 1024 + 32] = (bf16_t)(cvtpk(o01[r] * rl0, 0.f) & 0xffffu);
            op[(size_t)(32 + q) * 1024] = (bf16_t)(cvtpk(o10[r] * rl1, 0.f) & 0xffffu); op[(size_t)(32 + q) * 1024 + 32] = (bf16_t)(cvtpk(o11[r] * rl1, 0.f) & 0xffffu); }
    }
    __syncthreads();
}

template <int R, int NWQ, int MODE>
__device__ __forceinline__ void band_unit(LAS unsigned char* lds, const bf16_t* __restrict__ P, int qcol, int kcol, int vcol, int b, int rho, int rr, int i0, int n,
                                          const float* table, int tcol, float negMb, float sink2, bf16_t* O, int ldo, int ocol, float* L, int lidx, int lstride, const int tid_in) {
    constexpr int NQ = NWQ * 32, NK = NQ + 2 * R, NS = (32 + 2 * R) / 32, ROWB = 144, KS = 0, VS = NK * ROWB, BT = 2 * NK * ROWB, LSC = BT + 1040;
    static_assert(NK == 384, "staging loop assumes 384 keys");
    int tid_ = tid_in; asm volatile("" : "+v"(tid_)); const int tid = tid_, lane = tid & 63, wid = tid >> 6, r32 = lane & 31, hi = lane >> 5;
    const size_t rowbase = (size_t)b * SEQ + rho;
#pragma unroll
    for (int i = 0; i < 6; ++i) { const int c = tid + 512 * i, jj = c >> 3, part = c & 7, j = i0 - R + jj;
        u32x4 kv = {0, 0, 0, 0}, vv = {0, 0, 0, 0};
        if (j >= 0 && j < n) { const bf16_t* rp = P + (rowbase + (size_t)rr * j) * PW + part * 8; kv = *(const u32x4*)(rp + kcol); vv = *(const u32x4*)(rp + vcol); }
        *(LAS u32x4*)(lds + KS + jj * ROWB + part * 16) = kv; *(LAS u32x4*)(lds + VS + jj * ROWB + part * 16) = vv; }
    LAS float* bt = (LAS float*)(lds + BT);
    if (tid < 2 * R + 1) bt[tid] = table[t5_bucket((tid - R) * rr) * 10 + tcol] * LOG2E;
    __syncthreads();
    if (wid < NWQ) {
        const int ql = wid * 32 + r32;
        const bf16_t* qp = P + (rowbase + (size_t)rr * (i0 + ql)) * PW + qcol + hi * 8;
        bf16x8 qf[4];
#pragma unroll
        for (int kk = 0; kk < 4; ++kk) qf[kk] = *(const bf16x8*)(qp + kk * 16);
        f32x16 o0 = {}, o1 = {}; float lsum = 0.f;
        f32x16 negm;
#pragma unroll
        for (int r = 0; r < 16; ++r) negm[r] = negMb;
        const int g16 = (lane >> 4) & 1, i16 = lane & 15;
        const int kra = KS + (wid * 32 + kperm(r32)) * ROWB + hi * 16;
        const int vra = VS + (wid * 32 + 8 * hi + (i16 >> 2)) * ROWB + (16 * g16 + 4 * (i16 & 3)) * 2;
#pragma unroll 1
        for (int kt = 0; kt < NS; ++kt) {
            f32x16 s = negm;
#pragma unroll
            for (int kk = 0; kk < 4; ++kk) { const bf16x8 a = *(LAS const bf16x8*)(lds + kra + kt * 32 * ROWB + kk * 32); s = MFMA32(a, qf[kk], s); }
            float ls = 0.f;
#pragma unroll
            for (int r = 0; r < 16; ++r) {
                const int jj = wid * 32 + kt * 32 + (r & 7) + 8 * hi + 16 * (r >> 3);
                const int rel = jj - R - ql, j = i0 - R + jj;
                const bool ok = (rel >= -R) && (rel <= R) && (j >= 0) && (j < n);
                int bi = rel + R; bi = bi < 0 ? 0 : (bi > 2 * R ? 2 * R : bi);
                const float pv = __builtin_amdgcn_exp2f(s[r] + bt[bi]);
                s[r] = ok ? pv : 0.f; ls += s[r]; }
            lsum += ls;
#pragma unroll
            for (int st = 0; st < 2; ++st) {
                const u32x4 pw = {cvtpk(s[8 * st], s[8 * st + 1]), cvtpk(s[8 * st + 2], s[8 * st + 3]), cvtpk(s[8 * st + 4], s[8 * st + 5]), cvtpk(s[8 * st + 6], s[8 * st + 7])};
                LAS const unsigned char* vb = lds + vra + (kt * 32 + 16 * st) * ROWB;
                const v4i16_t l0 = vtr(vb), h0 = vtr(vb + 4 * ROWB), l1 = vtr(vb + 64), h1 = vtr(vb + 4 * ROWB + 64);
                const bf16x8 b0 = {l0[0], l0[1], l0[2], l0[3], h0[0], h0[1], h0[2], h0[3]}, b1 = {l1[0], l1[1], l1[2], l1[3], h1[0], h1[1], h1[2], h1[3]};
                const bf16x8 pf = __builtin_bit_cast(bf16x8, pw);
                o0 = MFMA32(pf, b0, o0); o1 = MFMA32(pf, b1, o1); }
        }
        lsum += __shfl_xor(lsum, 32);
        if (MODE == 1) lsum += __builtin_amdgcn_exp2f(sink2 + negMb);
        const size_t orow0 = rowbase + (size_t)rr * (i0 + wid * 32);
        if (MODE == 0) {
            if (hi == 0) L[(orow0 + (size_t)rr * r32) * lstride + lidx] = lsum;
            bf16_t* op = O + orow0 * ldo + ocol + r32;
#pragma unroll
            for (int r = 0; r < 16; ++r) { const size_t q = (size_t)rr * crow(r, hi);
                op[q * ldo] = (bf16_t)(cvtpk(o0[r], 0.f) & 0xffffu); op[q * ldo + 32] = (bf16_t)(cvtpk(o1[r], 0.f) & 0xffffu); }
        } else {
            LAS float* lscr = (LAS float*)(lds + LSC) + wid * 32;
            if (hi == 0) lscr[r32] = lsum;
            asm volatile("s_waitcnt lgkmcnt(0)" ::: "memory");
            bf16_t* op = O + orow0 * ldo + ocol + r32;
#pragma unroll
            for (int r = 0; r < 16; ++r) { const int q = crow(r, hi); const float rl = 1.f / lscr[q];
                op[(size_t)q * rr * ldo] = (bf16_t)(cvtpk(o0[r] * rl, 0.f) & 0xffffu); op[(size_t)q * rr * ldo + 32] = (bf16_t)(cvtpk(o1[r] * rl, 0.f) & 0xffffu); }
        }
    }
    __syncthreads();
}

__device__ __forceinline__ void phase_attn(const Params& p, int l, LAS unsigned char* lds, int G, int bx, const int tid) {
    const bf16_t* P = (const bf16_t*)(p.ws + WS_P); const bf16_t* QC = (const bf16_t*)(p.ws + WS_QC); const bf16_t* KC = (const bf16_t*)(p.ws + WS_KC); const bf16_t* KV = (const bf16_t*)(p.ws + WS_KV);
    bf16_t* OCAT = (bf16_t*)(p.ws + WS_OCAT); bf16_t* OA = (bf16_t*)(p.ws + WS_OA); float* LA = (float*)(p.ws + WS_LA);
    const float* C = (const float*)(p.ws + WS_CONST) + l * 8;
    const float mA = C[0], mB = C[1], mC = C[2];
    const int vcu = (G % 8 == 0) ? (bx % 8) * (G / 8) + bx / 8 : bx;
#ifndef REP_C
#define REP_C 1
#endif
#ifndef REP_B
#define REP_B 1
#endif
    for (int rep = 0; rep < REP_C; ++rep)
    for (int u = vcu; u < 768; u += G) { const int bh = u >> 5, qb = u & 31; attnC_unit(lds, QC, KC, KV, OCAT, -mC, bh / 6, bh % 6, qb, tid); }
    for (int rep = 0; rep < REP_B; ++rep)
    for (int u = bx; u < 2304 + 1024; u += G) {
        if (u < 2304) { const int cfg = u / 768, rem = u % 768, h = rem / 128, blk = rem % 128; const int rr = cfg == 0 ? 1 : (cfg == 1 ? 4 : 16);
            const int per = 32 / rr, seq = blk / per, ib = blk % per, b = seq / rr, rho = seq % rr;
            band_unit<64, 8, 0>(lds, P, PC_QA + h * 64, PC_KA + h * 64, PC_VA + h * 64, b, rho, rr, ib * 256, SEQ / rr, p.table, h, -mA, 0.f,
                                OA + (size_t)cfg * T * 384, 384, h * 64, LA + (size_t)cfg * T * 6, h, 6, tid); }
        else { const int v = u - 2304, h = v / 256, rem = v % 256, b = rem / 64, ib = rem % 64;
            band_unit<128, 4, 1>(lds, P, PC_QB + h * 64, PC_KB + (h >> 1) * 64, PC_VB + (h >> 1) * 64, b, 0, 1, ib * 128, SEQ, p.table, 6 + h, -mB, p.sink[l * 4 + h] * LOG2E,
                                 OCAT, 1024, 384 + h * 64, nullptr, 0, 0, tid); }
    }
}

__device__ __forceinline__ void phase_merge(const Params& p, int gw, int NGW, int lane) {
    bf16_t* OCAT = (bf16_t*)(p.ws + WS_OCAT); const bf16_t* OA = (const bf16_t*)(p.ws + WS_OA); const float* LA = (const float*)(p.ws + WS_LA);
    for (int row = gw; row < T; row += NGW) {
        float v0[8], v1[8]; float sa = 0.f, sb = 0.f, sc = 0.f;
        const int c0 = lane * 8, c1 = 512 + lane * 8;
        if (c0 < 384) { const int h = c0 >> 6; float a0[8], a1[8], a2[8];
            unpack8(*(const u32x4*)(OA + (size_t)row * 384 + c0), a0); unpack8(*(const u32x4*)(OA + ((size_t)T + row) * 384 + c0), a1); unpack8(*(const u32x4*)(OA + ((size_t)2 * T + row) * 384 + c0), a2);
            const float lt = LA[(size_t)row * 6 + h] + LA[((size_t)T + row) * 6 + h] + LA[((size_t)2 * T + row) * 6 + h]; const float rl = 1.f / lt;
#pragma unroll
            for (int e = 0; e < 8; ++e) { v0[e] = (a0[e] + a1[e] + a2[e]) * rl; sa += v0[e] * v0[e]; } }
        else { unpack8(*(const u32x4*)(OCAT + (size_t)row * 1024 + c0), v0);
#pragma unroll
            for (int e = 0; e < 8; ++e) sb += v0[e] * v0[e]; }
        unpack8(*(const u32x4*)(OCAT + (size_t)row * 1024 + c1), v1);
        { float s = 0.f;
#pragma unroll
            for (int e = 0; e < 8; ++e) s += v1[e] * v1[e];
            if (c1 < 640) sb += s; else sc += s; }
        sa = wave_sum(sa); sb = wave_sum(sb); sc = wave_sum(sc);
        const float ra = rsqrtf(sa * (1.f / 384.f) + EPS), rb = rsqrtf(sb * (1.f / 256.f) + EPS), rc = rsqrtf(sc * (1.f / 384.f) + EPS);
        const float r0 = c0 < 384 ? ra : rb, r1 = c1 < 640 ? rb : rc;
#pragma unroll
        for (int e = 0; e < 8; ++e) { v0[e] *= r0; v1[e] *= r1; }
        *(u32x4*)(OCAT + (size_t)row * 1024 + c0) = pack8(v0); *(u32x4*)(OCAT + (size_t)row * 1024 + c1) = pack8(v1);
    }
}

#define XB_TMO      128
#define XB_XCNT(j)  (256  + 64 * (j))
#define XB_XSUB(j)  (1280 + 64 * (j))
#define XB_XGEN(j)  (2304 + 64 * (j))
#define XB_TOP      3328
#define XB_TOPGEN   3392
#define XCD_BAR_WORDS 3456
#define XB_SPIN_CAP (1u << 18)

__device__ __forceinline__ unsigned xb_ld(unsigned* p)              { return __hip_atomic_load(p, __ATOMIC_RELAXED, __HIP_MEMORY_SCOPE_AGENT); }
__device__ __forceinline__ unsigned xb_add(unsigned* p, unsigned v) { return __hip_atomic_fetch_add(p, v, __ATOMIC_RELAXED, __HIP_MEMORY_SCOPE_AGENT); }
__device__ __forceinline__ unsigned xb_xcc_id() { return (unsigned)__builtin_amdgcn_s_getreg((3 << 11) | 20) & 0xFu; }
#define XB_SPIN(cond, bar) do { unsigned _sp = 0; while (cond) { __builtin_amdgcn_s_sleep(1); \
    if ((++_sp & 255u) == 0u) { if (xb_ld(&(bar)[XB_TMO])) break; if (_sp > XB_SPIN_CAP) { atomicAdd(&(bar)[XB_TMO], 1u); break; } } } } while (0)

struct XcdBarrier {
    unsigned* bar; unsigned x;
    volatile LAS unsigned* st;
};

__device__ __forceinline__ XcdBarrier xcd_barrier_post(unsigned* bar, volatile LAS unsigned* st) {
    XcdBarrier b; b.bar = bar; b.x = xb_xcc_id(); b.st = st;
    if (threadIdx.x == 0) (void)xb_add(&bar[XB_XCNT(b.x)], 1u);
    return b;
}
__device__ __forceinline__ void xcd_barrier_complete(unsigned* bar, unsigned x, unsigned& nloc, unsigned& nx) {
    const unsigned G = gridDim.x * gridDim.y * gridDim.z;
    unsigned sum, cnt, mine, sp = 0u;
    for (;;) {
        sum = 0u; cnt = 0u; mine = 0u;
#pragma unroll
        for (unsigned j = 0; j < 16; ++j) { const unsigned c = xb_ld(&bar[XB_XCNT(j)]); sum += c; cnt += (c > 0u) ? 1u : 0u; mine = (j == x) ? c : mine; }
        if (sum == G) break;
        __builtin_amdgcn_s_sleep(1);
        if ((++sp & 255u) == 0u) { if (xb_ld(&bar[XB_TMO])) break; if (sp > XB_SPIN_CAP) { atomicAdd(&bar[XB_TMO], 1u); break; } }
    }
    nloc = mine > 0u ? mine : 1u; nx = cnt > 0u ? cnt : 1u;
}

__device__ __forceinline__ void xcd_barrier(const XcdBarrier& b) {
    asm volatile("s_waitcnt vmcnt(0)" ::: "memory");
    __syncthreads();
    if (threadIdx.x == 0) {
        unsigned* bar = b.bar;
        __builtin_amdgcn_s_waitcnt(0);
        unsigned nloc = b.st[0], nx = b.st[1];
        if (nloc == 0u) { xcd_barrier_complete(bar, b.x, nloc, nx); b.st[0] = nloc; b.st[1] = nx; }
        const unsigned old = xb_add(&bar[XB_XSUB(b.x)], 1u);
        const unsigned gen = old / nloc;
        if (old + 1u == (gen + 1u) * nloc) {
            __builtin_amdgcn_fence(__ATOMIC_RELEASE, "agent");
            asm volatile("s_waitcnt vmcnt(0)" ::: "memory");
            const unsigned og = xb_add(&bar[XB_TOP], 1u);
            const unsigned tg = og / nx;
            if (og + 1u == (tg + 1u) * nx) xb_add(&bar[XB_TOPGEN], 1u);
            else XB_SPIN(xb_ld(&bar[XB_TOPGEN]) == tg, bar);
            __builtin_amdgcn_fence(__ATOMIC_ACQUIRE, "agent");
            xb_add(&bar[XB_XGEN(b.x)], 1u);
            asm volatile("s_waitcnt vmcnt(0)" ::: "memory");
        } else {
            XB_SPIN(xb_ld(&bar[XB_XGEN(b.x)]) == gen, bar);
            __builtin_amdgcn_fence(__ATOMIC_ACQUIRE, "agent");
            asm volatile("s_waitcnt vmcnt(0)" ::: "memory");
        }
    }
    __syncthreads();
}

constexpr int NPHASE = 1 + 10 * NLAYER;
template <int PH> __device__ __forceinline__ void run_phase(const Params& p, LAS unsigned char* lds, const int wave0) {
    int tid_ = threadIdx.x; asm volatile("" : "+v"(tid_)); const int tid = tid_, lane = tid & 63, wave = __builtin_amdgcn_readfirstlane(tid >> 6);
    const int G = gridDim.x, bx = blockIdx.x;
    const int gw = bx * 8 + wave, NGW = G * 8;
    bf16_t* XB = (bf16_t*)(p.ws + WS_XB); float* SSP = (float*)(p.ws + WS_SSP);
    if constexpr (PH == 0) { phase_prologue(p, lds, gw, NGW, wave, lane); }
    else {
        constexpr int l = (PH - 1) / 10, k = (PH - 1) % 10;
        const bf16_t* WL = (const bf16_t*)(p.ws + WS_W) + (size_t)l * WO_LAYER;
        if constexpr (k == 0) {
            pg8::Gemm g{XB, WL + WO_IN, T, 2304, 1024}; pg8::StaticOrder S; S.init(T, 2304, G, bx);
            EpiStore<true, false> E{(bf16_t*)(p.ws + WS_P), PW, PW, SSP};
            pg8::gemm_phase<EpiStore<true, false>, pg8::StaticOrder, true, true>(lds, g, S, E, tid);
        } else if constexpr (k == 1) { phase_postin(p, l, gw, NGW, lane);
        } else if constexpr (k == 2) {
            pg8::Gemm g{(const bf16_t*)(p.ws + WS_CQN), WL + WO_UQ, T, 768, 256}; pg8::StaticOrder S; S.init(T, 768, G, bx);
            EpiStore<false, false> E{(bf16_t*)(p.ws + WS_QC), 576, 576, nullptr};
            pg8::gemm_phase<EpiStore<false, false>, pg8::StaticOrder, true, true>(lds, g, S, E, tid);
        } else if constexpr (k == 9) {
            pg8::Gemm g{(const bf16_t*)(p.ws + WS_CKVN), WL + WO_UKV, T, 768, 128}; pg8::StaticOrder S; S.init(T, 768, G, bx);
            EpiStore<false, false> E{(bf16_t*)(p.ws + WS_KV), 768, 768, nullptr};
            pg8::gemm_phase<EpiStore<false, false>, pg8::StaticOrder, true, true>(lds, g, S, E, tid);
        } else if constexpr (k == 3) { phase_postlat(p, l, bx * 512 + tid, G * 512);
        } else if constexpr (k == 4) { phase_attn(p, l, lds, G, bx, tid);
        } else if constexpr (k == 5) { phase_merge(p, gw, NGW, lane);
        } else if constexpr (k == 6) {
            pg8::Gemm g{(const bf16_t*)(p.ws + WS_OCAT), WL + WO_OUT, T, 1024, 1024}; pg8::StaticOrder S; S.init(T, 1024, G, bx);
            EpiResid E{l == 0 ? p.x : p.out, p.out, XB, SSP};
            pg8::gemm_phase<EpiResid, pg8::StaticOrder, true, true>(lds, g, S, E, tid);
        } else if constexpr (k == 7) {
            pg8::Gemm g{XB, WL + WO_UP, T, 4096, 1024}; pg8::StaticOrder S; S.init(T, 4096, G, bx);
            EpiStore<true, true> E{(bf16_t*)(p.ws + WS_U), 4096, 4096, SSP};
            pg8::gemm_phase<EpiStore<true, true>, pg8::StaticOrder, true, true>(lds, g, S, E, tid);
        } else {
            pg8::Gemm g{(const bf16_t*)(p.ws + WS_U), WL + WO_DN, T, 1024, 4096}; pg8::StaticOrder S; S.init(T, 1024, G, bx);
            EpiResid E{p.out, p.out, XB, SSP};
            pg8::gemm_phase<EpiResid, pg8::StaticOrder, true, true>(lds, g, S, E, tid);
        }
    }
    __syncthreads();
}
#ifndef PROBE_DBL
#define PROBE_DBL(PH) false
#endif
#define PHASE(i, PH, SYNC) do { if (lo <= (i) && (i) < hi) { if ((i) > lo && (SYNC)) GRID_SYNC(); run_phase<(PH)>(p, lds, wave0); if (PROBE_DBL(PH)) { GRID_SYNC(); run_phase<(PH)>(p, lds, wave0); } } } while (0)
__global__ void __launch_bounds__(512, 2) fwd_kernel(Params p) {
    extern __shared__ __attribute__((aligned(16))) unsigned char smem[];
    LAS unsigned char* lds = (LAS unsigned char*)smem;
    const int lo = p.ph_lo, hi = p.ph_hi;
    const int wave0 = 0;
    volatile LAS unsigned* bst = (volatile LAS unsigned*)(lds + 131072 + 512);
    if (threadIdx.x == 0) { bst[0] = 0u; bst[1] = 0u; }
    __syncthreads();
    if (hi - lo > 1) (void)xcd_barrier_post((unsigned*)(p.ws + WS_BAR), bst);
    if (p.ph_lo == 12345) cg::this_grid().sync();
#define GRID_SYNC() do { XcdBarrier bar_; bar_.bar = (unsigned*)(p.ws + WS_BAR); bar_.x = xb_xcc_id(); bar_.st = (volatile LAS unsigned*)(lds + 131072 + 512); xcd_barrier(bar_); } while (0)
    PHASE(0, 0, true);
#ifdef PROBE_SYNC
    for (int i = 0; i < PROBE_SYNC; ++i) GRID_SYNC();
#endif
    PHASE(1, 1, true); PHASE(2, 2, true); PHASE(3, 3, true); PHASE(4, 10, false); PHASE(5, 4, true); PHASE(6, 5, true); PHASE(7, 6, true); PHASE(8, 7, true); PHASE(9, 8, true); PHASE(10, 9, true);
    PHASE(11, 11, true); PHASE(12, 12, true); PHASE(13, 13, true); PHASE(14, 20, false); PHASE(15, 14, true); PHASE(16, 15, true); PHASE(17, 16, true); PHASE(18, 17, true); PHASE(19, 18, true); PHASE(20, 19, true);
}

extern "C" void kernel_launch(void* const* d_in, const int* in_sizes, int n_in, void* d_out, int out_size, void* d_ws, size_t ws_size, hipStream_t stream) {
    static int grid = 0;
    if (grid == 0) {
        if (n_in != 18 || out_size != T * DM || ws_size < WS_END) { fprintf(stderr, "kernel_launch: unexpected shapes (n_in %d out %d ws %zu)\n", n_in, out_size, ws_size); grid = -1; return; }
        int dev = 0, cus = 0, per_cu = 0;
        (void)hipGetDevice(&dev); (void)hipDeviceGetAttribute(&cus, hipDeviceAttributeMultiprocessorCount, dev);
        if (hipFuncSetAttribute((const void*)fwd_kernel, hipFuncAttributeMaxDynamicSharedMemorySize, LDS_BYTES) != hipSuccess) fprintf(stderr, "kernel_launch: hipFuncSetAttribute failed\n");
        if (hipOccupancyMaxActiveBlocksPerMultiprocessor(&per_cu, (const void*)fwd_kernel, 512, LDS_BYTES) != hipSuccess || per_cu < 1) { fprintf(stderr, "kernel_launch: occupancy query says %d\n", per_cu); per_cu = 1; }
        (void)hipGetLastError();
        grid = cus > 0 ? cus : 256;
    }
    if (grid < 0) return;
    Params p{};
    p.x = (const float*)d_in[0]; p.pos = (const int*)d_in[1]; p.table = (const float*)d_in[2]; p.norm_mix = (const float*)d_in[3]; p.w_in = (const float*)d_in[4];
    p.gA = (const float*)d_in[5]; p.gB = (const float*)d_in[6]; p.sink = (const float*)d_in[7]; p.qlat = (const float*)d_in[8]; p.kvlat = (const float*)d_in[9];
    p.w_uq = (const float*)d_in[10]; p.w_ukv = (const float*)d_in[11]; p.gC = (const float*)d_in[12]; p.out_norm = (const float*)d_in[13]; p.w_out = (const float*)d_in[14];
    p.norm_mlp = (const float*)d_in[15]; p.w_up = (const float*)d_in[16]; p.w_down = (const float*)d_in[17];
    p.out = (float*)d_out; p.ws = (unsigned char*)d_ws;
#if MODE_COOP
    (void)hipMemsetAsync((char*)d_ws + WS_BAR, 0, WS_BAR_BYTES, stream);
    p.ph_lo = 0; p.ph_hi = NPHASE;
    void* args[] = {&p};
    hipError_t e = hipLaunchCooperativeKernel((const void*)fwd_kernel, dim3(grid), dim3(512), args, LDS_BYTES, stream);
    if (e != hipSuccess) fprintf(stderr, "kernel_launch: cooperative launch failed: %s\n", hipGetErrorString(e));
#else
    for (int ph = 0; ph < NPHASE; ++ph) { p.ph_lo = ph; p.ph_hi = ph + 1; hipLaunchKernelGGL(fwd_kernel, dim3(grid), dim3(512), LDS_BYTES, stream, p); }
#endif
}
```
